# Optimizing an MI355X kernel written in HIP

```python
import jax, jax.numpy as jnp
from jax import lax
import numpy as np

D_MODEL = 1024
BATCH = 32
SEQ = 2048
DEPTH = 1
DEC_BATCH = 16
DEC_SEQ = 64
PAST_LEN = 1024

CHUNK = 64
ML_HEADS = 4
ML_DHEAD = D_MODEL // ML_HEADS
ML_WIDTH = ML_HEADS * ML_DHEAD
CONV_W = 4
ATT_HEADS = 16
ATT_DHEAD = D_MODEL // ATT_HEADS
ATT_WIDTH = ATT_HEADS * ATT_DHEAD
BAND_CHUNKS = 8
MAX_REL = 128
D_FF = ((8 * D_MODEL) // 3 + 127) // 128 * 128
ALPHA = (2.0 * DEPTH) ** 0.25
BETA = (8.0 * DEPTH) ** -0.25
LN_EPS = 1e-5
NEG_INF = -1e30
SEG_SIZES = (ML_WIDTH,) * 4 + (ML_HEADS,) * 2 + (ATT_WIDTH,) * 3 + (D_MODEL,) * 2
SPLIT_IDX = [int(s) for s in np.cumsum(SEG_SIZES)[:-1]]
IN_WIDTH = int(sum(SEG_SIZES))

kernel_name = 'hybrid_streaming_mlstm_bandattn_step'


def layer_norm(x, g, b):
    xf = x.astype(jnp.float32)
    mu = jnp.mean(xf, axis=-1, keepdims=True)
    var = jnp.mean(jnp.square(xf - mu), axis=-1, keepdims=True)
    y = (xf - mu) * lax.rsqrt(var + LN_EPS) * g.astype(jnp.float32) + b.astype(jnp.float32)
    return y.astype(x.dtype)


def swiglu_ffn(x, w_gu, w_down):
    gate, up = jnp.split(x @ w_gu, 2, axis=-1)
    return (jax.nn.silu(gate) * up) @ w_down


def causal_dwconv(x_pad, w, b):
    t = x_pad.shape[1] - (CONV_W - 1)
    out = b
    for j in range(CONV_W):
        out = out + x_pad[:, j:j + t] * w[j]
    return out


def mlstm_chunk(carry, inp):
    C, n, m = carry
    q, k, v, lf, li = inp
    L = q.shape[2]
    bcum = jnp.cumsum(lf, axis=-1)
    causal = jnp.tril(jnp.ones((L, L), dtype=bool))
    dmat = jnp.where(causal, bcum[..., :, None] - bcum[..., None, :] + li[..., None, :], -jnp.inf)
    inter = bcum + m[..., None]
    m_t = jnp.maximum(inter, jnp.max(dmat, axis=-1))
    w_inter = jnp.exp(inter - m_t)
    s = jnp.einsum('bhtd,bhsd->bhts', q, k) * jnp.exp(dmat - m_t[..., None])
    num = w_inter[..., None] * jnp.einsum('bhtd,bhde->bhte', q, C) + jnp.einsum('bhts,bhse->bhte', s, v)
    den = w_inter * jnp.einsum('bhtd,bhd->bht', q, n) + jnp.sum(s, axis=-1)
    h = num / jnp.maximum(jnp.abs(den), jnp.exp(-m_t))[..., None]
    b_last = bcum[..., -1]
    g_s = b_last[..., None] - bcum + li
    m_new = jnp.maximum(b_last + m, jnp.max(g_s, axis=-1))
    decay = jnp.exp(b_last + m - m_new)
    w_s = jnp.exp(g_s - m_new[..., None])
    C_new = decay[..., None, None] * C + jnp.einsum('bhs,bhsd,bhse->bhde', w_s, k, v)
    n_new = decay[..., None] * n + jnp.einsum('bhs,bhsd->bhd', w_s, k)
    return (C_new, n_new, m_new), h


def mlstm_run(q, k, v, li, lf, state):
    b, h, t, _ = q.shape
    L = min(t, CHUNK)
    nc = t // L

    def blocks(a):
        return jnp.moveaxis(a.reshape(a.shape[:2] + (nc, L) + a.shape[3:]), 2, 0)

    state, hs = lax.scan(mlstm_chunk, state, (blocks(q), blocks(k), blocks(v), blocks(lf), blocks(li)))
    hs = jnp.moveaxis(hs, 0, 2).reshape(b, h, t, v.shape[-1])
    return hs, state


def rel_bias_block(table, q_pos, k_pos):
    rel = jnp.clip(q_pos[:, None] - k_pos[None, :], -MAX_REL, MAX_REL) + MAX_REL
    return table[:, rel].astype(jnp.float32)


def band_attention_prompt(q, k, v, table):
    b, t, h, d = q.shape
    nc = t // CHUNK
    pad = BAND_CHUNKS * CHUNK
    band = pad + CHUNK
    kp = jnp.pad(k, ((0, 0), (pad, 0), (0, 0), (0, 0)))
    vp = jnp.pad(v, ((0, 0), (pad, 0), (0, 0), (0, 0)))
    bias = rel_bias_block(table, pad + jnp.arange(CHUNK), jnp.arange(band))

    def one_chunk(c):
        qc = lax.dynamic_slice_in_dim(q, c * CHUNK, CHUNK, axis=1)
        kc = lax.dynamic_slice_in_dim(kp, c * CHUNK, band, axis=1)
        vc = lax.dynamic_slice_in_dim(vp, c * CHUNK, band, axis=1)
        s = jnp.einsum('bqhd,bkhd->bhqk', qc, kc).astype(jnp.float32) + bias
        k_valid = (c - BAND_CHUNKS) * CHUNK + jnp.arange(band) >= 0
        p = jax.nn.softmax(jnp.where(k_valid, s, NEG_INF), axis=-1)
        return jnp.einsum('bhqk,bkhd->bqhd', p.astype(vc.dtype), vc)

    o = lax.map(one_chunk, jnp.arange(nc))
    return jnp.moveaxis(o, 0, 1).reshape(b, t, h, d)


def band_attention_sample(q, k_new, v_new, k_past, v_past, table):
    n_past, t = k_past.shape[1], q.shape[1]
    kk = jnp.concatenate([k_past.astype(k_new.dtype), k_new], axis=1)
    vv = jnp.concatenate([v_past.astype(v_new.dtype), v_new], axis=1)
    bias = rel_bias_block(table, n_past + jnp.arange(t), jnp.arange(n_past + t))
    s = jnp.einsum('bqhd,bkhd->bhqk', q, kk).astype(jnp.float32) + bias
    p = jax.nn.softmax(s, axis=-1)
    return jnp.einsum('bhqk,bkhd->bqhd', p.astype(vv.dtype), vv)


def token_mixer(xn, p, conv_prev, ml_state, att_past):
    b, t, _ = xn.shape
    f32 = jnp.float32
    (ml_q, ml_k, ml_v, ml_o, ml_i, ml_f, a_q, a_k, a_v, g_ml, g_att) = jnp.split(xn @ p['w_in'], SPLIT_IDX, axis=-1)
    qk_pad = jnp.concatenate([conv_prev.astype(xn.dtype), jnp.concatenate([ml_q, ml_k], axis=-1)], axis=1)
    qk = jax.nn.silu(causal_dwconv(qk_pad, p['ml_conv_w'], p['ml_conv_b']))
    new_conv = qk_pad[:, qk_pad.shape[1] - (CONV_W - 1):]
    q_c, k_c = jnp.split(qk, 2, axis=-1)

    def ml_heads(a):
        return a.reshape(b, t, ML_HEADS, ML_DHEAD).transpose(0, 2, 1, 3).astype(f32)

    qm = ml_heads(q_c)
    km = ml_heads(k_c) * (ML_DHEAD ** -0.5)
    vm = ml_heads(ml_v)
    li = (ml_i + p['b_ml_i']).astype(f32).transpose(0, 2, 1)
    lf = jax.nn.log_sigmoid((ml_f + p['b_ml_f']).astype(f32)).transpose(0, 2, 1)
    C0, n0, m0 = ml_state
    h_ml, (C1, n1, m1) = mlstm_run(qm, km, vm, li, lf, (C0.astype(f32), n0.astype(f32), m0.astype(f32)))
    h_ml = h_ml.transpose(0, 2, 1, 3)
    mu = jnp.mean(h_ml, axis=-1, keepdims=True)
    var = jnp.mean(jnp.square(h_ml - mu), axis=-1, keepdims=True)
    h_ml = ((h_ml - mu) * lax.rsqrt(var + LN_EPS)).reshape(b, t, ML_WIDTH)
    h_ml = h_ml * p['ml_norm_g'].astype(f32) * jax.nn.sigmoid(ml_o.astype(f32))
    y_ml = h_ml.astype(xn.dtype) @ p['w_ml_proj']
    qa = a_q.reshape(b, t, ATT_HEADS, ATT_DHEAD) * (ATT_DHEAD ** -0.5)
    ka = a_k.reshape(b, t, ATT_HEADS, ATT_DHEAD)
    va = a_v.reshape(b, t, ATT_HEADS, ATT_DHEAD)
    if att_past is None:
        o = band_attention_prompt(qa, ka, va, p['att_rel_bias'])
        keep = min(BAND_CHUNKS * CHUNK, t)
        k_rows, v_rows = ka[:, t - keep:], va[:, t - keep:]
    else:
        o = band_attention_sample(qa, ka, va, att_past[0], att_past[1], p['att_rel_bias'])
        k_rows, v_rows = ka, va
    y_att = o.reshape(b, t, ATT_WIDTH) @ p['w_att_proj']
    merged = jax.nn.sigmoid(g_ml) * y_ml + jax.nn.sigmoid(g_att) * y_att
    new_state = (new_conv, C1.astype(xn.dtype), n1.astype(xn.dtype), m1.astype(xn.dtype), k_rows, v_rows)
    return merged @ p['w_out'], new_state


def encoder_layer(x, p, conv_prev, ml_state, att_past):
    h = layer_norm(ALPHA * x + 0.5 * swiglu_ffn(x, p['ffn1_w_gu'], p['ffn1_w_down']), p['ln1_g'], p['ln1_b'])
    mix, new_state = token_mixer(h, p, conv_prev, ml_state, att_past)
    h = layer_norm(ALPHA * h + mix, p['ln2_g'], p['ln2_b'])
    h = layer_norm(ALPHA * h + 0.5 * swiglu_ffn(h, p['ffn2_w_gu'], p['ffn2_w_down']), p['ln3_g'], p['ln3_b'])
    return h, new_state


def setup_inputs(seed: int = 0) -> dict:
    key = jax.random.key(seed)
    ks = jax.random.split(key, 32)
    f32 = jnp.float32

    def nrm(k, shape, scale):
        return jax.random.normal(k, shape, f32) * scale

    att_past = min(BAND_CHUNKS * CHUNK, PAST_LEN)
    col_scale = np.ones((IN_WIDTH,), np.float32)
    col_scale[SPLIT_IDX[1]:SPLIT_IDX[2]] = BETA
    col_scale[SPLIT_IDX[7]:SPLIT_IDX[8]] = BETA
    return {
        'x_prompt': nrm(ks[0], (BATCH, SEQ, D_MODEL), 1.0),
        'x_sample': nrm(ks[1], (DEC_BATCH, DEC_SEQ, D_MODEL), 1.0),
        'state_ml_conv': nrm(ks[2], (DEPTH, DEC_BATCH, CONV_W - 1, 2 * ML_WIDTH), 1.0),
        'state_ml_C': nrm(ks[3], (DEPTH, DEC_BATCH, ML_HEADS, ML_DHEAD, ML_DHEAD), 0.1),
        'state_ml_n': jnp.abs(nrm(ks[4], (DEPTH, DEC_BATCH, ML_HEADS, ML_DHEAD), 0.1)),
        'state_ml_m': nrm(ks[5], (DEPTH, DEC_BATCH, ML_HEADS), 0.5),
        'cache_att_k': nrm(ks[6], (DEPTH, DEC_BATCH, att_past, ATT_HEADS, ATT_DHEAD), 1.0),
        'cache_att_v': nrm(ks[7], (DEPTH, DEC_BATCH, att_past, ATT_HEADS, ATT_DHEAD), 1.0),
        'w_in': nrm(ks[8], (DEPTH, D_MODEL, IN_WIDTH), D_MODEL ** -0.5) * jnp.asarray(col_scale),
        'b_ml_i': nrm(ks[9], (DEPTH, ML_HEADS), 0.1),
        'b_ml_f': jnp.linspace(3.0, 6.0, ML_HEADS, dtype=f32) + nrm(ks[10], (DEPTH, ML_HEADS), 0.1),
        'ml_conv_w': nrm(ks[11], (DEPTH, CONV_W, 2 * ML_WIDTH), CONV_W ** -0.5),
        'ml_conv_b': nrm(ks[12], (DEPTH, 2 * ML_WIDTH), 0.02),
        'ml_norm_g': 1.0 + nrm(ks[13], (DEPTH, ML_WIDTH), 0.02),
        'att_rel_bias': nrm(ks[14], (DEPTH, ATT_HEADS, 2 * MAX_REL + 1), 0.5),
        'w_ml_proj': nrm(ks[15], (DEPTH, ML_WIDTH, D_MODEL), BETA * ML_WIDTH ** -0.5),
        'w_att_proj': nrm(ks[16], (DEPTH, ATT_WIDTH, D_MODEL), BETA * ATT_WIDTH ** -0.5),
        'w_out': nrm(ks[17], (DEPTH, D_MODEL, D_MODEL), BETA * D_MODEL ** -0.5),
        'ffn1_w_gu': nrm(ks[18], (DEPTH, D_MODEL, 2 * D_FF), D_MODEL ** -0.5),
        'ffn1_w_down': nrm(ks[19], (DEPTH, D_FF, D_MODEL), BETA * D_FF ** -0.5),
        'ffn2_w_gu': nrm(ks[20], (DEPTH, D_MODEL, 2 * D_FF), D_MODEL ** -0.5),
        'ffn2_w_down': nrm(ks[21], (DEPTH, D_FF, D_MODEL), BETA * D_FF ** -0.5),
        'ln1_g': 1.0 + nrm(ks[22], (DEPTH, D_MODEL), 0.02),
        'ln1_b': nrm(ks[23], (DEPTH, D_MODEL), 0.02),
        'ln2_g': 1.0 + nrm(ks[24], (DEPTH, D_MODEL), 0.02),
        'ln2_b': nrm(ks[25], (DEPTH, D_MODEL), 0.02),
        'ln3_g': 1.0 + nrm(ks[26], (DEPTH, D_MODEL), 0.02),
        'ln3_b': nrm(ks[27], (DEPTH, D_MODEL), 0.02),
    }


def reference(x_prompt, x_sample, state_ml_conv, state_ml_C, state_ml_n, state_ml_m, cache_att_k, cache_att_v,
              w_in, b_ml_i, b_ml_f, ml_conv_w, ml_conv_b, ml_norm_g, att_rel_bias, w_ml_proj, w_att_proj, w_out,
              ffn1_w_gu, ffn1_w_down, ffn2_w_gu, ffn2_w_down, ln1_g, ln1_b, ln2_g, ln2_b, ln3_g, ln3_b):
    f32 = jnp.float32
    bp = x_prompt.shape[0]
    y_prompt, y_sample = x_prompt, x_sample
    prompt_states, sample_states = [], []
    for l in range(DEPTH):
        p = {'w_in': w_in[l], 'b_ml_i': b_ml_i[l], 'b_ml_f': b_ml_f[l], 'ml_conv_w': ml_conv_w[l],
             'ml_conv_b': ml_conv_b[l], 'ml_norm_g': ml_norm_g[l], 'att_rel_bias': att_rel_bias[l],
             'w_ml_proj': w_ml_proj[l], 'w_att_proj': w_att_proj[l], 'w_out': w_out[l],
             'ffn1_w_gu': ffn1_w_gu[l], 'ffn1_w_down': ffn1_w_down[l], 'ffn2_w_gu': ffn2_w_gu[l],
             'ffn2_w_down': ffn2_w_down[l], 'ln1_g': ln1_g[l], 'ln1_b': ln1_b[l], 'ln2_g': ln2_g[l],
             'ln2_b': ln2_b[l], 'ln3_g': ln3_g[l], 'ln3_b': ln3_b[l]}
        conv0 = jnp.zeros((bp, CONV_W - 1, 2 * ML_WIDTH), x_prompt.dtype)
        ml0 = (jnp.zeros((bp, ML_HEADS, ML_DHEAD, ML_DHEAD), f32),
               jnp.zeros((bp, ML_HEADS, ML_DHEAD), f32),
               jnp.zeros((bp, ML_HEADS), f32))
        y_prompt, st_p = encoder_layer(y_prompt, p, conv0, ml0, None)
        y_sample, st_s = encoder_layer(y_sample, p, state_ml_conv[l],
                                       (state_ml_C[l], state_ml_n[l], state_ml_m[l]),
                                       (cache_att_k[l], cache_att_v[l]))
        prompt_states.append(st_p)
        sample_states.append(st_s)
    p_conv, p_C, p_n, p_m, p_k, p_v = [jnp.stack(s) for s in zip(*prompt_states)]
    s_conv, s_C, s_n, s_m, s_k, s_v = [jnp.stack(s) for s in zip(*sample_states)]
    return (y_prompt, y_sample, p_conv, s_conv, p_C, s_C, p_n, s_n, p_m, s_m, p_k, s_k, p_v, s_v)
```

```cpp
#include <hip/hip_runtime.h>
#include <hip/hip_cooperative_groups.h>
#include <cstdio>
#include <cstdint>
namespace cg = cooperative_groups;

#ifndef MK_ONE_LAUNCH
#define MK_ONE_LAUNCH 1
#endif

#define LAS __attribute__((address_space(3)))
typedef unsigned short bf16_t;
typedef short bf16x8 __attribute__((ext_vector_type(8)));
typedef short s16x4 __attribute__((ext_vector_type(4)));
typedef float f32x4 __attribute__((ext_vector_type(4)));
typedef unsigned u32x4 __attribute__((ext_vector_type(4)));
typedef unsigned u32x2 __attribute__((ext_vector_type(2)));

constexpr int DM = 1024, TP = 65536, TS = 1024, TT = TP + TS, FF = 2816, SEQ = 2048, NB = 32, NSB = 16, DSEQ = 64, NPAST = 512;
constexpr int INW = 9224;
constexpr float ALPHA = 1.189207115002721f;
constexpr float LN_EPS = 1e-5f;
constexpr size_t MiB = 1u << 20;
constexpr size_t SZ1 = (size_t)TT * DM * 2;
constexpr size_t WS_WGU1 = 0, WS_WD1 = 11 * MiB, WS_WGU2 = 17 * MiB, WS_WD2 = 28 * MiB, WS_WML = 34 * MiB, WS_WATT = 42 * MiB,
                 WS_WGM = 48 * MiB, WS_WGA = 50 * MiB, WS_WMLP = 52 * MiB, WS_WATTP = 54 * MiB, WS_WOUT = 56 * MiB, WS_WIF = 58 * MiB, WS_IF = 59 * MiB, WS_BAR = 63 * MiB;
constexpr size_t WS_HB = 64 * MiB;
constexpr size_t WS_ACT = 194 * MiB;
constexpr size_t WS_B0 = 194 * MiB;
constexpr size_t WS_CK = WS_B0 + 5 * SZ1, WS_CV = WS_CK + 16 * MiB, WS_GSCR = WS_CV + 16 * MiB, WS_END = WS_GSCR + 96 * MiB;
static_assert(WS_END <= 1024 * MiB, "ws map");
constexpr size_t O_Y = 0, O_PCONV = (size_t)TT * DM, O_SCONV = O_PCONV + 32 * 3 * 2048, O_PC = O_SCONV + 16 * 3 * 2048, O_SC = O_PC + (size_t)32 * 4 * 65536,
                 O_PN = O_SC + (size_t)16 * 4 * 65536, O_SN = O_PN + 32 * 4 * 256, O_PM = O_SN + 16 * 4 * 256, O_SM = O_PM + 128, O_PK = O_SM + 64,
                 O_SK = O_PK + (size_t)32 * 512 * 1024, O_PV = O_SK + (size_t)16 * 64 * 1024, O_SV = O_PV + (size_t)32 * 512 * 1024, O_END = O_SV + (size_t)16 * 64 * 1024;

constexpr int LDS_BYTES = 147456;

__device__ __forceinline__ unsigned pk2(float lo, float hi) { unsigned r; asm volatile("v_cvt_pk_bf16_f32 %0, %1, %2" : "=v"(r) : "v"(lo), "v"(hi)); return r; }
__device__ __forceinline__ float bflo(unsigned w) { return __uint_as_float(w << 16); }
__device__ __forceinline__ float bfhi(unsigned w) { return __uint_as_float(w & 0xffff0000u); }
__device__ __forceinline__ float bf1(bf16_t b) { return __uint_as_float(((unsigned)b) << 16); }
__device__ __forceinline__ float rcpf_(float x) { return __builtin_amdgcn_rcpf(x); }
__device__ __forceinline__ float sigmoidf_(float x) { return __builtin_amdgcn_rcpf(1.0f + __expf(-x)); }
__device__ __forceinline__ float wave_sum(float v) {
#pragma unroll
    for (int o = 1; o < 64; o <<= 1) v += __shfl_xor(v, o);
    return v;
}
__device__ __forceinline__ s16x4 tr_read(const LAS unsigned char* p) {
    typedef short v4i16_t __attribute__((ext_vector_type(4)));
    return __builtin_bit_cast(s16x4, __builtin_amdgcn_ds_read_tr16_b64_v4i16((LAS v4i16_t*)p));
}


#define XB_TMO      128
#define XB_XCNT(j)  (256  + 64 * (j))
#define XB_XSUB(j)  (1280 + 64 * (j))
#define XB_XGEN(j)  (2304 + 64 * (j))
#define XB_TOP      3328
#define XB_TOPGEN   3392
#define XCD_BAR_WORDS 3456
#define XB_SPIN_CAP (1u << 22)
__device__ __forceinline__ unsigned xb_ld(unsigned* p)              { return __hip_atomic_load(p, __ATOMIC_RELAXED, __HIP_MEMORY_SCOPE_AGENT); }
__device__ __forceinline__ unsigned xb_add(unsigned* p, unsigned v) { return __hip_atomic_fetch_add(p, v, __ATOMIC_RELAXED, __HIP_MEMORY_SCOPE_AGENT); }
__device__ __forceinline__ unsigned xb_xcc_id() { return (unsigned)__builtin_amdgcn_s_getreg((3 << 11) | 20) & 0xFu; }
#define XB_SPIN(cond, bar) do { unsigned _sp = 0; while (cond) { __builtin_amdgcn_s_sleep(1); \
    if ((++_sp & 255u) == 0u) { if (xb_ld(&(bar)[XB_TMO])) break; if (_sp > XB_SPIN_CAP) { atomicAdd(&(bar)[XB_TMO], 1u); break; } } } } while (0)
struct XcdBarrier { unsigned* bar; unsigned x; volatile LAS unsigned* st; };
__device__ __forceinline__ XcdBarrier xcd_barrier_post(unsigned* bar, volatile LAS unsigned* st) {
    XcdBarrier b; b.bar = bar; b.x = xb_xcc_id(); b.st = st;
    if (threadIdx.x == 0) (void)xb_add(&bar[XB_XCNT(b.x)], 1u);
    return b;
}
__device__ __forceinline__ void xcd_barrier_complete(unsigned* bar, unsigned x, unsigned& nloc, unsigned& nx) {
    const unsigned G = gridDim.x * gridDim.y * gridDim.z;
    unsigned sum, cnt, mine, sp = 0u;
    for (;;) {
        sum = 0u; cnt = 0u; mine = 0u;
#pragma unroll
        for (unsigned j = 0; j < 16; ++j) { const unsigned c = xb_ld(&bar[XB_XCNT(j)]); sum += c; cnt += (c > 0u) ? 1u : 0u; mine = (j == x) ? c : mine; }
        if (sum == G) break;
        __builtin_amdgcn_s_sleep(1);
        if ((++sp & 255u) == 0u) { if (xb_ld(&bar[XB_TMO])) break; if (sp > XB_SPIN_CAP) { atomicAdd(&bar[XB_TMO], 1u); break; } }
    }
    nloc = mine > 0u ? mine : 1u; nx = cnt > 0u ? cnt : 1u;
}
__device__ __forceinline__ void xcd_barrier(unsigned* bar_, volatile LAS unsigned* st_) {
    XcdBarrier b; b.bar = bar_; b.st = st_; b.x = xb_xcc_id();
    asm volatile("s_waitcnt vmcnt(0)" ::: "memory");
    __syncthreads();
    if (threadIdx.x == 0) {
        unsigned* bar = b.bar;
        __builtin_amdgcn_s_waitcnt(0);
        unsigned nloc = b.st[0], nx = b.st[1];
        if (nloc == 0u) { xcd_barrier_complete(bar, b.x, nloc, nx); b.st[0] = nloc; b.st[1] = nx; }
        const unsigned old = xb_add(&bar[XB_XSUB(b.x)], 1u);
        const unsigned gen = old / nloc;
        if (old + 1u == (gen + 1u) * nloc) {
            __builtin_amdgcn_fence(__ATOMIC_RELEASE, "agent");
            asm volatile("s_waitcnt vmcnt(0)" ::: "memory");
            const unsigned og = xb_add(&bar[XB_TOP], 1u);
            const unsigned tg = og / nx;
            if (og + 1u == (tg + 1u) * nx) xb_add(&bar[XB_TOPGEN], 1u);
            else XB_SPIN(xb_ld(&bar[XB_TOPGEN]) == tg, bar);
            __builtin_amdgcn_fence(__ATOMIC_ACQUIRE, "agent");
            xb_add(&bar[XB_XGEN(b.x)], 1u);
            asm volatile("s_waitcnt vmcnt(0)" ::: "memory");
        } else {
            XB_SPIN(xb_ld(&bar[XB_XGEN(b.x)]) == gen, bar);
            __builtin_amdgcn_fence(__ATOMIC_ACQUIRE, "agent");
            asm volatile("s_waitcnt vmcnt(0)" ::: "memory");
        }
    }
    __syncthreads();
}

namespace pg8 {
constexpr int BM = 256, BK = 64, HALF = 128, HTB = HALF * BK * 2, STAGE_BYTES = 8 * HTB, NXCD = 8, WGM = 8;
__host__ __device__ __forceinline__ int lds_byte(int r, int c) { const int st = (r >> 4) * 2 + (c >> 5), rr = r & 15, cc = c & 31, ob = rr * 64 + cc * 2; return st * 1024 + (ob ^ (((ob >> 9) & 1) << 5)); }
__host__ __device__ __forceinline__ void stage_rc(int b, int& R, int& C) { const int st = b / 1024, sb = b % 1024, swz = sb ^ (((sb >> 9) & 1) << 5); R = (st >> 1) * 16 + swz / 64; C = (st & 1) * 32 + (swz % 64) / 2; }
__host__ __device__ __forceinline__ int perm32(int rho) { const int n = rho >> 4, i = rho & 15; return 8 * (i >> 2) + 4 * n + (i & 3); }

struct Unit { int pm, pn, seg; };
struct Gemm { const bf16_t* A[4]; const bf16_t* Bt[4]; int M, N, K;
    __device__ __forceinline__ const char* a(int sg) const { return (const char*)(sg == 0 ? A[0] : sg == 1 ? A[1] : sg == 2 ? A[2] : A[3]); }
    __device__ __forceinline__ const char* b(int sg) const { return (const char*)(sg == 0 ? Bt[0] : sg == 1 ? Bt[1] : sg == 2 ? Bt[2] : Bt[3]); } };

struct StaticOrder {
    int nM, nN, nwg, G, c, nseg, pm_off;
    __device__ void init(int M, int N, int G_, int c_, int nseg_, int pm_off_ = 0) { nM = M / BM; nN = N / BM; nwg = nM * nN; G = G_; c = c_; nseg = nseg_; pm_off = pm_off_; }
    __device__ bool next(int ii, Unit& u) const {
        const int i = ii / nseg; u.seg = ii - i * nseg;
        const long L = (long)i * G + c; if (L >= nwg) return false;
        int wgid = (int)L; { const int q = nwg / NXCD, r = nwg % NXCD, xcd = wgid % NXCD, off = wgid / NXCD; wgid = (xcd < r ? xcd * (q + 1) : r * (q + 1) + (xcd - r) * q) + off; }
        const int nig = WGM * nN, gid = wgid / nig, fm = gid * WGM, gsz = (nM - fm) < WGM ? (nM - fm) : WGM;
        u.pm = pm_off + fm + ((wgid % nig) % gsz); u.pn = (wgid % nig) / gsz; return true;
    }
};

template <class Epi, class Sched>
__device__ __forceinline__ void gemm_phase(LAS unsigned char* lds, const Gemm g, const Sched& S, const Epi& E) {
    const int tid = threadIdx.x, wid = __builtin_amdgcn_readfirstlane(tid >> 6), lane = tid & 63, wr = wid >> 2, wc = wid & 3, fr = lane & 15, fq = lane >> 4;
    const int K = g.K, nt = K / BK;
    unsigned voffA[2], voffB[2];
#pragma unroll
    for (int i = 0; i < 2; ++i) { int R, C; stage_rc(tid * 16 + i * 8192, R, C); const int Rb = Epi::PERM ? ((R & ~31) + perm32(R & 31)) : R;
        voffA[i] = (unsigned)(R * K + C) * 2u; voffB[i] = (unsigned)(Rb * K + C) * 2u; }
    const size_t kstep = (size_t)(BK * 2);
    const size_t hstep = (size_t)HALF * K * 2;
    const size_t tstep = 2 * hstep;
    const unsigned ldsw = (unsigned)wid * 1024u;
    const int aoff = lds_byte(wr * 64 + fr, fq * 8), boff = lds_byte(wc * 32 + fr, fq * 8);
#define PG8_SA(b, h) (((b) * 2 + (h)) * HTB)
#define PG8_SB(b, h) ((4 + (b) * 2 + (h)) * HTB)
#define PG8_STAGE(bufoff, gbase, voff) do { _Pragma("unroll") for (int _i = 0; _i < 2; ++_i) \
        __builtin_amdgcn_global_load_lds((const unsigned*)((const char*)(gbase) + (voff)[_i]), (LAS unsigned*)(lds + (bufoff) + ldsw + _i * 8192), 16, 0, 0); } while (0)
#define PG8_LDA(dst, b, h) do { _Pragma("unroll") for (int m = 0; m < 4; ++m) _Pragma("unroll") for (int k = 0; k < 2; ++k) dst[m][k] = *(const LAS bf16x8*)(lds + PG8_SA(b, h) + aoff + m * 2048 + k * 1024); } while (0)
#define PG8_LDB(dst, b, h) do { _Pragma("unroll") for (int n = 0; n < 2; ++n) _Pragma("unroll") for (int k = 0; k < 2; ++k) dst[n][k] = *(const LAS bf16x8*)(lds + PG8_SB(b, h) + boff + n * 2048 + k * 1024); } while (0)
#define PG8_MMA(ai, bj, At, Bt) do { __builtin_amdgcn_s_setprio(1); _Pragma("unroll") for (int m = 0; m < 4; ++m) _Pragma("unroll") for (int n = 0; n < 2; ++n) _Pragma("unroll") for (int k = 0; k < 2; ++k) \
        acc[ai][bj][m][n] = __builtin_amdgcn_mfma_f32_16x16x32_bf16(Bt[n][k], At[m][k], acc[ai][bj][m][n], 0, 0, 0); __builtin_amdgcn_s_setprio(0); } while (0)
#define PG8_WAIT_V(n) asm volatile("s_waitcnt vmcnt(" #n ")" ::: "memory")
#define PG8_WAIT_L(n) asm volatile("s_waitcnt lgkmcnt(" #n ")" ::: "memory")
#define PG8_BAR __builtin_amdgcn_s_barrier()
#define PG8_SCHED __builtin_amdgcn_sched_barrier(0)
    Unit cur, nxt; int ui = 0;
    if (!S.next(0, cur)) return;
    f32x4 acc[2][2][4][2];
#pragma unroll
    for (int a = 0; a < 2; ++a)
#pragma unroll
        for (int b = 0; b < 2; ++b)
#pragma unroll
            for (int m = 0; m < 4; ++m)
#pragma unroll
                for (int n = 0; n < 2; ++n) acc[a][b][m][n] = (f32x4){0.f, 0.f, 0.f, 0.f};
    bf16x8 At[4][2], B0[2][2], B1[2][2];
    const char* cA = g.a(cur.seg) + (size_t)cur.pm * tstep; const char* cB = g.b(cur.seg) + (size_t)cur.pn * tstep;
    PG8_STAGE(PG8_SB(0, 0), cB, voffB); PG8_STAGE(PG8_SB(0, 1), cB + hstep, voffB); PG8_STAGE(PG8_SA(0, 0), cA, voffA); PG8_STAGE(PG8_SA(0, 1), cA + hstep, voffA);
    if (wr == 1) PG8_BAR;
    PG8_WAIT_V(2); PG8_BAR;
    PG8_STAGE(PG8_SB(1, 0), cB + kstep, voffB); PG8_STAGE(PG8_SA(1, 0), cA + kstep, voffA); PG8_STAGE(PG8_SB(1, 1), cB + hstep + kstep, voffB);
    PG8_WAIT_V(6); PG8_BAR;
    for (;;) {
        const bool has_next = S.next(ui + 1, nxt);
        const char* nA = has_next ? g.a(nxt.seg) + (size_t)nxt.pm * tstep : cA; const char* nB = has_next ? g.b(nxt.seg) + (size_t)nxt.pn * tstep : cB;
        for (int t = 0; t < nt; t += 2) {
            const bool last = (t == nt - 2);
            const char* a1 = cA + (size_t)(t + 1) * kstep;
            const char* a2 = last ? nA : cA + (size_t)(t + 2) * kstep; const char* b2 = last ? nB : cB + (size_t)(t + 2) * kstep;
            const char* a3 = a2 + kstep; const char* b3 = b2 + kstep;
            PG8_LDB(B0, 0, 0); PG8_LDB(B1, 0, 1); PG8_SCHED; PG8_LDA(At, 0, 0); PG8_STAGE(PG8_SA(1, 1), a1 + hstep, voffA);
            PG8_WAIT_V(8); PG8_WAIT_L(0); PG8_BAR; PG8_MMA(0, 0, At, B0); PG8_MMA(0, 1, At, B1); PG8_BAR; PG8_SCHED;
            PG8_LDA(At, 0, 1); PG8_STAGE(PG8_SB(0, 0), b2, voffB); PG8_STAGE(PG8_SB(0, 1), b2 + hstep, voffB); PG8_STAGE(PG8_SA(0, 0), a2, voffA);
            PG8_WAIT_V(8); PG8_WAIT_L(0); PG8_BAR; PG8_MMA(1, 0, At, B0); PG8_MMA(1, 1, At, B1); PG8_BAR; PG8_SCHED;
            PG8_LDB(B0, 1, 0); PG8_LDB(B1, 1, 1); PG8_SCHED; PG8_LDA(At, 1, 0); PG8_STAGE(PG8_SA(0, 1), a2 + hstep, voffA);
            PG8_WAIT_V(8); PG8_WAIT_L(0); PG8_BAR; PG8_MMA(0, 0, At, B0); PG8_MMA(0, 1, At, B1); PG8_BAR; PG8_SCHED;
            PG8_LDA(At, 1, 1); PG8_STAGE(PG8_SB(1, 0), b3, voffB); PG8_STAGE(PG8_SB(1, 1), b3 + hstep, voffB); PG8_STAGE(PG8_SA(1, 0), a3, voffA);
            PG8_WAIT_V(8); PG8_WAIT_L(0); PG8_BAR; PG8_MMA(1, 0, At, B0); PG8_MMA(1, 1, At, B1); PG8_BAR; PG8_SCHED;
        }
        if (wr == 0) PG8_BAR;
        E(acc, cur, wr, wc, fr, fq);
        if (!has_next) break;
        if (!(Epi::KEEP && E.keep(cur))) {
#pragma unroll
            for (int a = 0; a < 2; ++a)
#pragma unroll
                for (int b = 0; b < 2; ++b)
#pragma unroll
                    for (int m = 0; m < 4; ++m)
#pragma unroll
                        for (int n = 0; n < 2; ++n) acc[a][b][m][n] = (f32x4){0.f, 0.f, 0.f, 0.f};
        }
        cur = nxt; cA = nA; cB = nB; ++ui;
        if (wr == 1) PG8_BAR;
    }
    PG8_WAIT_V(0);
    PG8_BAR;
#undef PG8_SA
#undef PG8_SB
#undef PG8_STAGE
#undef PG8_LDA
#undef PG8_LDB
#undef PG8_MMA
#undef PG8_WAIT_V
#undef PG8_WAIT_L
#undef PG8_BAR
#undef PG8_SCHED
}

struct EpiSwiglu {
    static constexpr bool PERM = true, KEEP = false;
    bf16_t* O;
    __device__ __forceinline__ bool keep(const Unit&) const { return false; }
    __device__ __forceinline__ void operator()(f32x4 (&acc)[2][2][4][2], const Unit& u, int wr, int wc, int fr, int fq) const {
        const int row0 = u.pm * BM + wr * 64 + fr, col0 = u.pn * 128 + wc * 32 + 8 * fq;
#pragma unroll
        for (int ai = 0; ai < 2; ++ai)
#pragma unroll
            for (int m = 0; m < 4; ++m) {
                bf16_t* rowp = O + (size_t)(row0 + ai * HALF + m * 16) * FF + col0;
                float v[8];
#pragma unroll
                for (int n = 0; n < 2; ++n)
#pragma unroll
                    for (int i = 0; i < 4; ++i) { const float gt = acc[ai][0][m][n][i], up = acc[ai][1][m][n][i]; v[n * 4 + i] = gt * sigmoidf_(gt) * up; }
                u32x4 w; w.x = pk2(v[0], v[1]); w.y = pk2(v[2], v[3]); w.z = pk2(v[4], v[5]); w.w = pk2(v[6], v[7]);
                *(u32x4*)rowp = w;
            }
    }
};
struct EpiResid {
    static constexpr bool PERM = false, KEEP = false;
    bf16_t* U; const float* xp; const float* xs; const bf16_t* hb; float scale; int mode;
    __device__ __forceinline__ bool keep(const Unit&) const { return false; }
    __device__ __forceinline__ void operator()(f32x4 (&acc)[2][2][4][2], const Unit& u, int wr, int wc, int fr, int fq) const {
        const int row0 = u.pm * BM + wr * 64 + fr, col0 = u.pn * BM + wc * 32 + 4 * fq;
#pragma unroll
        for (int ai = 0; ai < 2; ++ai)
#pragma unroll
            for (int m = 0; m < 4; ++m) {
                const int r = row0 + ai * HALF + m * 16;
                bf16_t* op = U + (size_t)r * DM;
                if (mode == 0) {
                    const float* bp = (r < TP ? xp + (size_t)r * DM : xs + (size_t)(r - TP) * DM);
#pragma unroll
                    for (int bj = 0; bj < 2; ++bj)
#pragma unroll
                        for (int n = 0; n < 2; ++n) { const int c = col0 + bj * HALF + n * 16; const f32x4 b = *(const f32x4*)(bp + c); const f32x4 o = b * ALPHA + acc[ai][bj][m][n] * scale; *(u32x2*)(op + c) = (u32x2){pk2(o[0], o[1]), pk2(o[2], o[3])}; }
                } else {
                    const bf16_t* bp = hb + (size_t)r * DM;
#pragma unroll
                    for (int bj = 0; bj < 2; ++bj)
#pragma unroll
                        for (int n = 0; n < 2; ++n) { const int c = col0 + bj * HALF + n * 16; const u32x2 w = *(const u32x2*)(bp + c);
                            const f32x4 b = (f32x4){bflo(w.x), bfhi(w.x), bflo(w.y), bfhi(w.y)}; const f32x4 o = b * ALPHA + acc[ai][bj][m][n] * scale; *(u32x2*)(op + c) = (u32x2){pk2(o[0], o[1]), pk2(o[2], o[3])}; }
                }
            }
    }
};
struct EpiSplitBf16 {
    static constexpr bool PERM = true, KEEP = false;
    bf16_t* dst[7]; float* pk; float* sk; float* pv; float* sv; int kt, vt;
    __device__ __forceinline__ bool keep(const Unit&) const { return false; }
    __device__ __forceinline__ void operator()(f32x4 (&acc)[2][2][4][2], const Unit& u, int wr, int wc, int fr, int fq) const {
        const int t = u.pn >> 2; bf16_t* base = (t == 0 ? dst[0] : t == 1 ? dst[1] : t == 2 ? dst[2] : t == 3 ? dst[3] : t == 4 ? dst[4] : t == 5 ? dst[5] : dst[6]);
        const int row0 = u.pm * BM + wr * 64 + fr, col0 = (u.pn & 3) * BM + wc * 32 + 8 * fq;
        float* fbase = nullptr;
        if (t == kt || t == vt) {
            if (u.pm >= 256) fbase = (t == kt ? sk : sv) + (size_t)(u.pm * BM - TP) * DM;
            else if ((u.pm & 7) >= 6) fbase = (t == kt ? pk : pv) + ((size_t)(u.pm >> 3) * 512 + (size_t)((u.pm & 7) - 6) * 256) * DM;
        }
#pragma unroll
        for (int ai = 0; ai < 2; ++ai)
#pragma unroll
            for (int m = 0; m < 4; ++m) {
                const int r = row0 + ai * HALF + m * 16;
                bf16_t* rowp = base + (size_t)r * DM + col0;
#pragma unroll
                for (int bj = 0; bj < 2; ++bj) {
                    const f32x4 v0 = acc[ai][bj][m][0], v1 = acc[ai][bj][m][1];
                    u32x4 w; w.x = pk2(v0[0], v0[1]); w.y = pk2(v0[2], v0[3]); w.z = pk2(v1[0], v1[1]); w.w = pk2(v1[2], v1[3]);
                    *(u32x4*)(rowp + bj * HALF) = w;
                    if (fbase) { float* fp = fbase + (size_t)(r - u.pm * BM) * DM + col0 + bj * HALF; *(f32x4*)fp = v0; *(f32x4*)(fp + 4) = v1; }
                }
            }
    }
};
struct EpiMerge {
    static constexpr bool PERM = true, KEEP = false;
    bf16_t* MG; u32x4* scr;
    __device__ __forceinline__ bool keep(const Unit&) const { return false; }
    __device__ __forceinline__ void operator()(const f32x4 (&acc)[2][2][4][2], const Unit& u, int wr, int wc, int fr, int fq) const {
        const int tid = threadIdx.x;
        const int row0 = u.pm * BM + wr * 64 + fr, col0 = u.pn * BM + wc * 32 + 8 * fq;
#define PINP(x) asm volatile("" : "+v"(x))
        if (u.seg == 0 || u.seg == 2) {
            int qa = tid; PINP(qa);
#pragma unroll
            for (int k = 0; k < 16; ++k) {
                const f32x4 v0 = acc[k >> 3][k & 1][(k >> 1) & 3][0], v1 = acc[k >> 3][k & 1][(k >> 1) & 3][1];
                u32x4 w; w.x = pk2(sigmoidf_(v0[0]), sigmoidf_(v0[1])); w.y = pk2(sigmoidf_(v0[2]), sigmoidf_(v0[3]));
                w.z = pk2(sigmoidf_(v1[0]), sigmoidf_(v1[1])); w.w = pk2(sigmoidf_(v1[2]), sigmoidf_(v1[3]));
                scr[qa] = w; qa += 512; PINP(qa);
            }
        } else if (u.seg == 1) {
            int qa = tid, qc = tid + 16 * 512; PINP(qa); PINP(qc);
#pragma unroll
            for (int k = 0; k < 16; ++k) {
                const f32x4 v0 = acc[k >> 3][k & 1][(k >> 1) & 3][0], v1 = acc[k >> 3][k & 1][(k >> 1) & 3][1];
                const u32x4 a = scr[qa];
                const f32x4 c0 = (f32x4){v0[0] * bflo(a.x), v0[1] * bfhi(a.x), v0[2] * bflo(a.y), v0[3] * bfhi(a.y)};
                const f32x4 c1 = (f32x4){v1[0] * bflo(a.z), v1[1] * bfhi(a.z), v1[2] * bflo(a.w), v1[3] * bfhi(a.w)};
                *(f32x4*)(scr + qc) = c0; *(f32x4*)(scr + qc + 512) = c1;
                qa += 512; qc += 1024; PINP(qa); PINP(qc);
            }
        } else {
            int qa = tid, qc = tid + 16 * 512; PINP(qa); PINP(qc);
            int mo = row0 * DM + col0; PINP(mo);
#pragma unroll
            for (int k = 0; k < 16; ++k) {
                const int ai = k >> 3, bj = k & 1, m = (k >> 1) & 3;
                const f32x4 v0 = acc[ai][bj][m][0], v1 = acc[ai][bj][m][1];
                const u32x4 b = scr[qa];
                const f32x4 c0 = *(const f32x4*)(scr + qc), c1 = *(const f32x4*)(scr + qc + 512);
                u32x4 w; w.x = pk2(c0[0] + v0[0] * bflo(b.x), c0[1] + v0[1] * bfhi(b.x)); w.y = pk2(c0[2] + v0[2] * bflo(b.y), c0[3] + v0[3] * bfhi(b.y));
                w.z = pk2(c1[0] + v1[0] * bflo(b.z), c1[1] + v1[1] * bfhi(b.z)); w.w = pk2(c1[2] + v1[2] * bflo(b.w), c1[3] + v1[3] * bfhi(b.w));
                *(u32x4*)(MG + mo + (ai * HALF + m * 16) * DM + bj * HALF) = w;
                qa += 512; qc += 1024; PINP(qa); PINP(qc);
            }
        }
#undef PINP
    }
};
}

struct Args {
    const float* in[28];
    float* out; unsigned char* ws;
    int ph_lo, ph_hi;
};
enum { I_XP = 0, I_XS, I_SCONV, I_SC, I_SN, I_SM, I_CK, I_CV, I_WIN, I_BI, I_BF, I_CONVW, I_CONVB, I_MLNG, I_RELB, I_WMLP, I_WATTP, I_WOUT,
       I_GU1, I_D1, I_GU2, I_D2, I_LN1G, I_LN1B, I_LN2G, I_LN2B, I_LN3G, I_LN3B };

__device__ __forceinline__ void transpose_item(const float* W, int ldw, int col0, int K, int N, bf16_t* WT, int mode, LAS float* scr, int item, int lane) {
    const int nblk = N / 32, kb = item / nblk, nb = item % nblk, k0 = 64 * kb, n0 = 32 * nb;
    {
        const int n4 = (lane & 7) * 4, kq = lane >> 3;
        f32x4 wv[8];
#pragma unroll
        for (int i = 0; i < 8; ++i) wv[i] = *(const f32x4*)(W + (size_t)(k0 + kq + 8 * i) * ldw + col0 + n0 + n4);
#pragma unroll
        for (int i = 0; i < 8; ++i) { LAS float* d = scr + (kq + 8 * i) * 33 + n4; d[0] = wv[i][0]; d[1] = wv[i][1]; d[2] = wv[i][2]; d[3] = wv[i][3]; }
    }
    asm volatile("s_waitcnt lgkmcnt(0)" ::: "memory");
    const int c = lane & 7;
#pragma unroll
    for (int j = 0; j < 4; ++j) { const int nn = (lane >> 3) + 8 * j; const LAS float* s = scr + (8 * c) * 33 + nn;
        u32x4 o; o.x = pk2(s[0 * 33], s[1 * 33]); o.y = pk2(s[2 * 33], s[3 * 33]); o.z = pk2(s[4 * 33], s[5 * 33]); o.w = pk2(s[6 * 33], s[7 * 33]);
        const int n = n0 + nn;
        const int drow = (mode == 1) ? (256 * ((n % FF) / 128) + 128 * (n / FF) + (n % 128)) : n;
        *(u32x4*)(WT + (size_t)drow * K + k0 + 8 * c) = o; }
    asm volatile("s_waitcnt lgkmcnt(0)" ::: "memory");
}
__device__ __forceinline__ void cvt_f32_bf16(const float* src, bf16_t* dst, size_t n8, size_t i0, size_t stride) {
    for (size_t i = i0; i < n8; i += stride) {
        const f32x4 a = *(const f32x4*)(src + i * 8), b = *(const f32x4*)(src + i * 8 + 4);
        u32x4 w; w.x = pk2(a[0], a[1]); w.y = pk2(a[2], a[3]); w.z = pk2(b[0], b[1]); w.w = pk2(b[2], b[3]);
        *(u32x4*)(dst + i * 8) = w;
    }
}
__device__ __forceinline__ void p0_prologue(const Args& a, LAS unsigned char* lds) {
    const int tid = threadIdx.x, lane = tid & 63, wave = tid >> 6;
    LAS float* scr = (LAS float*)(lds + wave * 16384);
    const int gw = blockIdx.x * 8 + wave, NGW = gridDim.x * 8;
    unsigned char* ws = a.ws;
    constexpr int I_GU = (DM / 64) * (2 * FF / 32), I_DN = (FF / 64) * (DM / 32), I_ML = (DM / 64) * (4096 / 32), I_AT = (DM / 64) * (3072 / 32), I_SQ = (DM / 64) * (DM / 32);
    constexpr int NITEMS = 2 * I_GU + 2 * I_DN + I_ML + I_AT + 5 * I_SQ;
    for (int it = gw; it < NITEMS; it += NGW) {
        int r = it;
        if (r < I_GU) { transpose_item(a.in[I_GU1], 2 * FF, 0, DM, 2 * FF, (bf16_t*)(ws + WS_WGU1), 1, scr, r, lane); continue; } r -= I_GU;
        if (r < I_GU) { transpose_item(a.in[I_GU2], 2 * FF, 0, DM, 2 * FF, (bf16_t*)(ws + WS_WGU2), 1, scr, r, lane); continue; } r -= I_GU;
        if (r < I_DN) { transpose_item(a.in[I_D1], DM, 0, FF, DM, (bf16_t*)(ws + WS_WD1), 0, scr, r, lane); continue; } r -= I_DN;
        if (r < I_DN) { transpose_item(a.in[I_D2], DM, 0, FF, DM, (bf16_t*)(ws + WS_WD2), 0, scr, r, lane); continue; } r -= I_DN;
        if (r < I_ML) { transpose_item(a.in[I_WIN], INW, 0, DM, 4096, (bf16_t*)(ws + WS_WML), 0, scr, r, lane); continue; } r -= I_ML;
        if (r < I_AT) { transpose_item(a.in[I_WIN], INW, 4104, DM, 3072, (bf16_t*)(ws + WS_WATT), 0, scr, r, lane); continue; } r -= I_AT;
        if (r < I_SQ) { transpose_item(a.in[I_WIN], INW, 7176, DM, DM, (bf16_t*)(ws + WS_WGM), 0, scr, r, lane); continue; } r -= I_SQ;
        if (r < I_SQ) { transpose_item(a.in[I_WIN], INW, 8200, DM, DM, (bf16_t*)(ws + WS_WGA), 0, scr, r, lane); continue; } r -= I_SQ;
        if (r < I_SQ) { transpose_item(a.in[I_WMLP], DM, 0, DM, DM, (bf16_t*)(ws + WS_WMLP), 0, scr, r, lane); continue; } r -= I_SQ;
        if (r < I_SQ) { transpose_item(a.in[I_WATTP], DM, 0, DM, DM, (bf16_t*)(ws + WS_WATTP), 0, scr, r, lane); continue; } r -= I_SQ;
        transpose_item(a.in[I_WOUT], DM, 0, DM, DM, (bf16_t*)(ws + WS_WOUT), 0, scr, r, lane);
    }
    const size_t gt = (size_t)blockIdx.x * 512 + tid, NT = (size_t)gridDim.x * 512;
    for (size_t i = gt; i < 8 * 1024; i += NT) { const int c = (int)(i >> 10), k = (int)(i & 1023); ((float*)(ws + WS_WIF))[i] = a.in[I_WIN][(size_t)k * INW + 4096 + c]; }
    cvt_f32_bf16(a.in[I_XP], (bf16_t*)(ws + WS_HB), (size_t)TP * DM / 8, gt, NT);
    cvt_f32_bf16(a.in[I_XS], (bf16_t*)(ws + WS_HB) + (size_t)TP * DM, (size_t)TS * DM / 8, gt, NT);
    cvt_f32_bf16(a.in[I_CK], (bf16_t*)(ws + WS_CK), (size_t)NSB * NPAST * DM / 8, gt, NT);
    cvt_f32_bf16(a.in[I_CV], (bf16_t*)(ws + WS_CV), (size_t)NSB * NPAST * DM / 8, gt, NT);
}

template <int MODE>
__device__ __forceinline__ void ln_pass(const bf16_t* Ub, float* Yout, bf16_t* HB, const float* g, const float* bta, const float* WIF, float* IFo, int row_lo, int row_hi, int cu_lo, int ncu) {
    int tid = threadIdx.x; asm volatile("" : "+v"(tid)); const int lane = tid & 63, wave = tid >> 6;
    const int gw = ((int)blockIdx.x - cu_lo) * 8 + wave, NGW = ncu * 8;
    if (gw < 0 || gw >= NGW) return;
    constexpr int R = (MODE == 1) ? 2 : 4;
    f32x4 gg[4], bb[4];
#pragma unroll
    for (int j = 0; j < 4; ++j) { gg[j] = *(const f32x4*)(g + 4 * lane + 256 * j); bb[j] = *(const f32x4*)(bta + 4 * lane + 256 * j); }
    f32x4 wif[MODE == 1 ? 8 : 1][4];
    if (MODE == 1) {
#pragma unroll
        for (int c = 0; c < 8; ++c)
#pragma unroll
            for (int j = 0; j < 4; ++j) wif[c][j] = *(const f32x4*)(WIF + c * 1024 + 4 * lane + 256 * j);
    }
    for (int row0 = row_lo + gw * R; row0 < row_hi; row0 += NGW * R) {
        f32x4 v[R][4]; float s[R], s2[R];
#pragma unroll
        for (int r = 0; r < R; ++r) {
            const bf16_t* ur = Ub + (size_t)(row0 + r) * DM + 4 * lane;
#pragma unroll
            for (int j = 0; j < 4; ++j) { const u32x2 w = *(const u32x2*)(ur + 256 * j); v[r][j] = (f32x4){bflo(w.x), bfhi(w.x), bflo(w.y), bfhi(w.y)}; }
        }
#pragma unroll
        for (int r = 0; r < R; ++r) { s[r] = 0.f;
#pragma unroll
            for (int j = 0; j < 4; ++j) s[r] += (v[r][j][0] + v[r][j][1]) + (v[r][j][2] + v[r][j][3]); }
#pragma unroll
        for (int o = 1; o < 64; o <<= 1) {
#pragma unroll
            for (int r = 0; r < R; ++r) s[r] += __shfl_xor(s[r], o); }
#pragma unroll
        for (int r = 0; r < R; ++r) { const float mean = s[r] * (1.f / DM); s2[r] = 0.f;
#pragma unroll
            for (int j = 0; j < 4; ++j) { v[r][j] = v[r][j] - mean; s2[r] += (v[r][j][0] * v[r][j][0] + v[r][j][1] * v[r][j][1]) + (v[r][j][2] * v[r][j][2] + v[r][j][3] * v[r][j][3]); } }
#pragma unroll
        for (int o = 1; o < 64; o <<= 1) {
#pragma unroll
            for (int r = 0; r < R; ++r) s2[r] += __shfl_xor(s2[r], o); }
#pragma unroll
        for (int r = 0; r < R; ++r) {
            const float rstd = 1.f / sqrtf(s2[r] * (1.f / DM) + LN_EPS);
#pragma unroll
            for (int j = 0; j < 4; ++j) v[r][j] = v[r][j] * rstd * gg[j] + bb[j];
            if (MODE == 3) {
                float* ur = Yout + (size_t)(row0 + r) * DM + 4 * lane;
#pragma unroll
                for (int j = 0; j < 4; ++j) *(f32x4*)(ur + 256 * j) = v[r][j];
            } else {
                bf16_t* hr = HB + (size_t)(row0 + r) * DM + 4 * lane;
#pragma unroll
                for (int j = 0; j < 4; ++j) { u32x2 w; w.x = pk2(v[r][j][0], v[r][j][1]); w.y = pk2(v[r][j][2], v[r][j][3]); *(u32x2*)(hr + 256 * j) = w; }
            }
        }
        if (MODE == 1) {
#pragma unroll
            for (int r = 0; r < R; ++r) {
                float d[8];
#pragma unroll
                for (int c = 0; c < 8; ++c) { d[c] = 0.f;
#pragma unroll
                    for (int j = 0; j < 4; ++j) { const f32x4 w = wif[MODE == 1 ? c : 0][j]; d[c] += (v[r][j][0] * w[0] + v[r][j][1] * w[1]) + (v[r][j][2] * w[2] + v[r][j][3] * w[3]); } }
                const bool b0 = lane & 1, b1 = lane & 2, b2 = lane & 4;
                float e[4], f[2], hsum;
#pragma unroll
                for (int i = 0; i < 4; ++i) { const float t_ = __shfl_xor(b0 ? d[i] : d[i + 4], 1); e[i] = (b0 ? d[i + 4] : d[i]) + t_; }
#pragma unroll
                for (int i = 0; i < 2; ++i) { const float t_ = __shfl_xor(b1 ? e[i] : e[i + 2], 2); f[i] = (b1 ? e[i + 2] : e[i]) + t_; }
                { const float t_ = __shfl_xor(b2 ? f[0] : f[1], 4); hsum = (b2 ? f[1] : f[0]) + t_; }
                hsum += __shfl_xor(hsum, 8); hsum += __shfl_xor(hsum, 16); hsum += __shfl_xor(hsum, 32);
                const int col = (b0 ? 4 : 0) + (b1 ? 2 : 0) + (b2 ? 1 : 0);
                if (lane < 8) IFo[(size_t)(row0 + r) * 8 + col] = hsum;
            }
        }
    }
}

__device__ __forceinline__ void headln_pass(bf16_t* H, const bf16_t* MLO, const float* ng) {
    int tid = threadIdx.x; asm volatile("" : "+v"(tid)); const int lane = tid & 63, wave = tid >> 6;
    const int gw = blockIdx.x * 8 + wave, NGW = gridDim.x * 8;
    const int c0 = (lane >> 4) * 256 + (lane & 15) * 16;
    float gv[16];
#pragma unroll
    for (int i = 0; i < 16; ++i) gv[i] = ng[c0 + i];
    for (int rowb = gw; rowb < TT; rowb += 2 * NGW) {
        u32x4 a0[2], a1[2], o0[2], o1[2];
#pragma unroll
        for (int q = 0; q < 2; ++q) {
            const int row = (rowb + q * NGW < TT) ? rowb + q * NGW : rowb;
            a0[q] = *(const u32x4*)(H + (size_t)row * DM + c0); a1[q] = *(const u32x4*)(H + (size_t)row * DM + c0 + 8);
            o0[q] = *(const u32x4*)(MLO + (size_t)row * DM + c0); o1[q] = *(const u32x4*)(MLO + (size_t)row * DM + c0 + 8);
        }
#pragma unroll
        for (int q = 0; q < 2; ++q) {
            const int row = rowb + q * NGW;
            float v[16], og[16];
            const unsigned aw[8] = {a0[q].x, a0[q].y, a0[q].z, a0[q].w, a1[q].x, a1[q].y, a1[q].z, a1[q].w}, ow[8] = {o0[q].x, o0[q].y, o0[q].z, o0[q].w, o1[q].x, o1[q].y, o1[q].z, o1[q].w};
#pragma unroll
            for (int i = 0; i < 8; ++i) { v[2 * i] = bflo(aw[i]); v[2 * i + 1] = bfhi(aw[i]); og[2 * i] = bflo(ow[i]); og[2 * i + 1] = bfhi(ow[i]); }
            float sm = 0.f;
#pragma unroll
            for (int i = 0; i < 16; ++i) sm += v[i];
#pragma unroll
            for (int o = 1; o < 16; o <<= 1) sm += __shfl_xor(sm, o);
            const float mean = sm * (1.f / 256.f); float s2 = 0.f;
#pragma unroll
            for (int i = 0; i < 16; ++i) { v[i] -= mean; s2 += v[i] * v[i]; }
#pragma unroll
            for (int o = 1; o < 16; o <<= 1) s2 += __shfl_xor(s2, o);
            const float rstd = 1.f / sqrtf(s2 * (1.f / 256.f) + LN_EPS);
            unsigned w[8];
#pragma unroll
            for (int i = 0; i < 8; ++i) w[i] = pk2(v[2 * i] * rstd * gv[2 * i] * sigmoidf_(og[2 * i]), v[2 * i + 1] * rstd * gv[2 * i + 1] * sigmoidf_(og[2 * i + 1]));
            if (row < TT) {
                *(u32x4*)(H + (size_t)row * DM + c0) = (u32x4){w[0], w[1], w[2], w[3]};
                *(u32x4*)(H + (size_t)row * DM + c0 + 8) = (u32x4){w[4], w[5], w[6], w[7]};
            }
        }
    }
}

namespace ml {
constexpr int QS = 0, KS = 35840, VS = 71680, VW = 91136, PS = 110592, CW = 119808, NV = 130048, SC = 131072;
constexpr int QROW = 560, VROW = 304, PROW = 144;
constexpr int S_A = 0, S_PM = 256, S_WI = 512, S_EMT = 768, S_WS = 1024, S_RS0 = 1280, S_RS1 = 1536, S_QN = 1792, S_DEC = 2048, S_PAR = 2304;
static_assert(KS - QS >= 64 * QROW && VS - KS >= 64 * QROW && VW - VS >= 64 * VROW && PS - VW >= 64 * VROW && CW - PS >= 64 * PROW && NV - CW >= 10240 && SC - NV >= 1024 && SC + 2 * S_PAR <= LDS_BYTES - 64, "mlstm lds");

__device__ __forceinline__ void mlstm_item(const Args& a, LAS unsigned char* lds, int item) {
    const int tid = threadIdx.x, lane = tid & 63, wid = __builtin_amdgcn_readfirstlane(tid >> 6), fr = lane & 15, g = lane >> 4;
    const bool sample = item >= 256; const int it = sample ? item - 256 : item;
    const int b = it >> 3, h = (it >> 1) & 3, half = it & 1;
    const int row0 = sample ? TP + b * DSEQ : b * SEQ, nch = sample ? 1 : SEQ / 64;
    unsigned char* ws = a.ws;
    const bf16_t* MLQ = (const bf16_t*)(ws + WS_B0); const bf16_t* MLK = (const bf16_t*)(ws + WS_B0 + SZ1); const bf16_t* MLV = (const bf16_t*)(ws + WS_B0 + 2 * SZ1);
    const float* IFb = (const float*)(ws + WS_IF);
    float* out = a.out;
    const int e0 = 16 * wid;
    const int ecol = h * 256 + half * 128;
    LAS float* cw = (LAS float*)(lds + CW);
    for (int i = tid; i < 2 * 5 * 256; i += 512) { const int mat = i / 1280, r = (i % 1280) / 256, ch = i & 255; const int gc = mat * 1024 + h * 256 + ch;
        cw[i] = (r < 4) ? a.in[I_CONVW][r * 2048 + gc] : a.in[I_CONVB][gc]; }
    LAS float* nv = (LAS float*)(lds + NV);
    if (tid < 256) nv[tid] = sample ? a.in[I_SN][(b * 4 + h) * 256 + tid] : 0.f;
    f32x4 accC[16];
#pragma unroll
    for (int dt = 0; dt < 16; ++dt) accC[dt] = (f32x4){0.f, 0.f, 0.f, 0.f};
    if (sample) {
#pragma unroll
        for (int dt = 0; dt < 16; ++dt) { const float* cp = a.in[I_SC] + ((size_t)(b * 4 + h) * 256 + 16 * dt + 4 * g) * 256 + half * 128 + e0 + fr;
            accC[dt] = (f32x4){cp[0], cp[256], cp[512], cp[768]}; }
    }
    for (int i = tid; i < 2 * 3 * 256; i += 512) { const int mat = i / 768, r = (i % 768) / 256, ch = i & 255;
        const float v = sample ? a.in[I_SCONV][((size_t)b * 3 + r) * 2048 + mat * 1024 + h * 256 + ch] : 0.f;
        *(LAS bf16_t*)(lds + PS + i * 2) = (bf16_t)(pk2(v, 0.f) & 0xffffu); }
    float mstate = sample ? a.in[I_SM][b * 4 + h] : 0.f;
    const float bi = __int_as_float(__builtin_amdgcn_readfirstlane(__float_as_int(a.in[I_BI][h]))), bfg = __int_as_float(__builtin_amdgcn_readfirstlane(__float_as_int(a.in[I_BF][h])));
    __syncthreads();
    const int cmat = tid >> 8, chp2 = (tid & 127) * 2, rh = (tid >> 7) & 1;
    const int eg8 = (tid & 15) * 8, vr0 = 4 * ((tid >> 4) & 15);
    unsigned raw[35];
    {
        const bf16_t* src = (cmat ? MLK : MLQ) + h * 256 + chp2;
#pragma unroll
        for (int r = 0; r < 35; ++r) { int t = 32 * rh - 3 + r; if (t < 0) t = 0; raw[r] = *(const unsigned*)(src + ((size_t)row0 + t) * DM); }
        if (rh == 0) {
#pragma unroll
            for (int r = 0; r < 3; ++r) raw[r] = *(const LAS unsigned*)(lds + PS + (cmat * 768 + r * 256 + chp2) * 2);
        }
    }
    float pxi = 0.f, pxf = 0.f;
    if (wid == 0) { pxi = IFb[((size_t)row0 + lane) * 8 + h]; pxf = IFb[((size_t)row0 + lane) * 8 + 4 + h]; }
    for (int c = 0; c < nch; ++c) {
        const int par = c & 1;
        LAS float* sc = (LAS float*)(lds + SC + par * S_PAR);
        const size_t rbase = (size_t)row0 + (size_t)c * 64;
        if (wid == 0) {
            const float xi = pxi + bi;
            const float xf = pxf + bfg;
            if (c + 1 < nch) { pxi = IFb[(rbase + 64 + lane) * 8 + h]; pxf = IFb[(rbase + 64 + lane) * 8 + 4 + h]; }
            const float lf = fminf(xf, 0.f) - __logf(1.0f + __expf(-fabsf(xf)));
            float bc = lf;
#pragma unroll
            for (int o = 1; o < 64; o <<= 1) { const float t_ = __shfl_up(bc, o); if (lane >= o) bc += t_; }
            const float av = xi - bc;
            float pmx = av;
#pragma unroll
            for (int o = 1; o < 64; o <<= 1) { const float t_ = __shfl_up(pmx, o); if (lane >= o) pmx = fmaxf(pmx, t_); }
            pmx = fmaxf(pmx, mstate);
            const float pm63 = __shfl(pmx, 63), b63 = __shfl(bc, 63);
            sc[S_A / 4 + lane] = av; sc[S_PM / 4 + lane] = pmx; sc[S_WI / 4 + lane] = __expf(mstate - pmx); sc[S_EMT / 4 + lane] = __expf(-(bc + pmx));
            sc[S_WS / 4 + lane] = __expf(av - pm63);
            if (lane == 0) sc[S_DEC / 4] = __expf(mstate - pm63);
            mstate = __int_as_float(__builtin_amdgcn_readfirstlane(__float_as_int(b63 + pm63)));
        }
        const bool conv_out = (c == nch - 1 && half == 0 && rh == 1);
        __syncthreads();
#ifndef NO_CONV
        u32x4 rv[4];
        {
            if (conv_out) {
                float* co = out + (sample ? O_SCONV : O_PCONV) + (size_t)b * 3 * 2048 + cmat * 1024 + h * 256 + chp2;
#pragma unroll
                for (int j = 0; j < 3; ++j) { const unsigned x = raw[32 + j]; co[j * 2048] = bflo(x); co[j * 2048 + 1] = bfhi(x); }
            }
            const LAS float* w = cw + cmat * 1280 + chp2;
            float wl[5], wh[5];
#pragma unroll
            for (int j = 0; j < 5; ++j) { wl[j] = w[j * 256]; wh[j] = w[j * 256 + 1]; }
            const float scl = cmat ? 0.0625f : 1.0f;
            LAS unsigned char* dstS = lds + (cmat ? KS : QS) + (32 * rh) * QROW + chp2 * 2;
            float x0l = bflo(raw[0]), x0h = bfhi(raw[0]), x1l = bflo(raw[1]), x1h = bfhi(raw[1]), x2l = bflo(raw[2]), x2h = bfhi(raw[2]);
#pragma unroll
            for (int t = 0; t < 32; ++t) {
                const float x3l = bflo(raw[t + 3]), x3h = bfhi(raw[t + 3]);
                float ol = __builtin_fmaf(wl[0], x0l, wl[4]), oh = __builtin_fmaf(wh[0], x0h, wh[4]);
                ol = __builtin_fmaf(wl[1], x1l, ol); oh = __builtin_fmaf(wh[1], x1h, oh);
                ol = __builtin_fmaf(wl[2], x2l, ol); oh = __builtin_fmaf(wh[2], x2h, oh);
                ol = __builtin_fmaf(wl[3], x3l, ol); oh = __builtin_fmaf(wh[3], x3h, oh);
                ol = ol * sigmoidf_(ol) * scl; oh = oh * sigmoidf_(oh) * scl;
                *(LAS unsigned*)(dstS + t * QROW) = pk2(ol, oh);
                x0l = x1l; x0h = x1h; x1l = x2l; x1h = x2h; x2l = x3l; x2h = x3h;
            }
        }
        if (tid < 256) {
#pragma unroll
            for (int r = 0; r < 4; ++r) rv[r] = *(const u32x4*)(MLV + (rbase + vr0 + r) * DM + ecol + eg8);
#pragma unroll
            for (int r = 0; r < 4; ++r) {
                const float wsv = sc[S_WS / 4 + vr0 + r]; const u32x4 x = rv[r];
                *(LAS u32x4*)(lds + VS + (vr0 + r) * VROW + eg8 * 2) = x;
                *(LAS u32x4*)(lds + VW + (vr0 + r) * VROW + eg8 * 2) = (u32x4){pk2(bflo(x.x) * wsv, bfhi(x.x) * wsv), pk2(bflo(x.y) * wsv, bfhi(x.y) * wsv),
                                                                              pk2(bflo(x.z) * wsv, bfhi(x.z) * wsv), pk2(bflo(x.w) * wsv, bfhi(x.w) * wsv)};
            }
        }
#endif
        __syncthreads();
        if (c + 1 < nch) {
            const bf16_t* src = (cmat ? MLK : MLQ) + h * 256 + chp2 + (rbase + 64 + 32 * rh - 3) * DM;
#pragma unroll
            for (int r = 0; r < 35; ++r) raw[r] = *(const unsigned*)(src + (size_t)r * DM);
        }
#ifndef NO_S
        {
            const int tt = wid & 3, sh = wid >> 2;
            f32x4 sa[2] = {(f32x4){0.f, 0.f, 0.f, 0.f}, (f32x4){0.f, 0.f, 0.f, 0.f}};
            int qoff = QS + (16 * tt + fr) * QROW + 16 * g, koff = KS + (32 * sh + fr) * QROW + 16 * g;
            asm volatile("" : "+v"(qoff), "+v"(koff));
            bf16x8 sq[2][2], sk[2][2][2];
#define LD_S(bi, kp) do { _Pragma("unroll") for (int k2 = 0; k2 < 2; ++k2) { sq[bi][k2] = *(const LAS bf16x8*)(lds + qoff + 64 * (2 * (kp) + k2)); \
                _Pragma("unroll") for (int st2 = 0; st2 < 2; ++st2) sk[bi][k2][st2] = *(const LAS bf16x8*)(lds + koff + st2 * 16 * QROW + 64 * (2 * (kp) + k2)); } } while (0)
            LD_S(0, 0);
#pragma unroll
            for (int kp = 0; kp < 4; ++kp) {
                if (kp < 3) LD_S((kp + 1) & 1, kp + 1);
                __builtin_amdgcn_sched_barrier(0);
#pragma unroll
                for (int k2 = 0; k2 < 2; ++k2)
#pragma unroll
                    for (int st2 = 0; st2 < 2; ++st2) sa[st2] = __builtin_amdgcn_mfma_f32_16x16x32_bf16(sk[kp & 1][k2][st2], sq[kp & 1][k2], sa[st2], 0, 0, 0);
                __builtin_amdgcn_sched_barrier(0);
            }
#undef LD_S
            const int t = 16 * tt + fr; const float pmt = sc[S_PM / 4 + t]; float rs = 0.f;
#pragma unroll
            for (int st2 = 0; st2 < 2; ++st2) {
                const int s0 = 16 * (2 * sh + st2) + 4 * g;
                const f32x4 av = *(const LAS f32x4*)(sc + S_A / 4 + s0);
                float p[4];
#pragma unroll
                for (int jj = 0; jj < 4; ++jj) { p[jj] = (s0 + jj <= t) ? sa[st2][jj] * __expf(av[jj] - pmt) : 0.f; rs += p[jj]; }
                *(LAS u32x2*)(lds + PS + t * PROW + s0 * 2) = (u32x2){pk2(p[0], p[1]), pk2(p[2], p[3])};
            }
            rs += __shfl_xor(rs, 16); rs += __shfl_xor(rs, 32);
            if (g == 0) sc[(sh ? S_RS1 : S_RS0) / 4 + t] = rs;
            int tidS = tid; asm volatile("" : "+v"(tidS)); const int tq = tidS >> 3, part = tidS & 7; float d = 0.f;
#pragma unroll
            for (int i = 0; i < 4; ++i) {
                const u32x4 x = *(const LAS u32x4*)(lds + QS + tq * QROW + (32 * part + 8 * i) * 2);
                const f32x4 n0 = *(const LAS f32x4*)(nv + 32 * part + 8 * i), n1 = *(const LAS f32x4*)(nv + 32 * part + 8 * i + 4);
                d += bflo(x.x) * n0[0] + bfhi(x.x) * n0[1] + bflo(x.y) * n0[2] + bfhi(x.y) * n0[3] + bflo(x.z) * n1[0] + bfhi(x.z) * n1[1] + bflo(x.w) * n1[2] + bfhi(x.w) * n1[3];
            }
            d += __shfl_xor(d, 1); d += __shfl_xor(d, 2); d += __shfl_xor(d, 4);
            if (part == 0) sc[S_QN / 4 + tq] = d;
        }
#endif
        __syncthreads();
#ifndef NO_H
        {
            f32x4 ao[4] = {(f32x4){0.f, 0.f, 0.f, 0.f}, (f32x4){0.f, 0.f, 0.f, 0.f}, (f32x4){0.f, 0.f, 0.f, 0.f}, (f32x4){0.f, 0.f, 0.f, 0.f}};
            int qa = QS + fr * QROW + 8 * g;
            asm volatile("" : "+v"(qa));
            u32x2 xq[2][2][4][2];
#define LD_Q(bi, kp) do { _Pragma("unroll") for (int k2 = 0; k2 < 2; ++k2) _Pragma("unroll") for (int tt = 0; tt < 4; ++tt) { \
                xq[bi][k2][tt][0] = *(const LAS u32x2*)(lds + qa + tt * 16 * QROW + 64 * (2 * (kp) + k2)); xq[bi][k2][tt][1] = *(const LAS u32x2*)(lds + qa + tt * 16 * QROW + 64 * (2 * (kp) + k2) + 32); } } while (0)
            LD_Q(0, 0);
#pragma unroll
            for (int kp = 0; kp < 4; ++kp) {
                if (kp < 3) LD_Q((kp + 1) & 1, kp + 1);
                __builtin_amdgcn_sched_barrier(0);
#pragma unroll
                for (int k2 = 0; k2 < 2; ++k2) {
                    const int kk = 2 * kp + k2;
                    const f32x4 c0 = accC[2 * kk], c1 = accC[2 * kk + 1];
                    const u32x4 bw = (u32x4){pk2(c0[0], c0[1]), pk2(c0[2], c0[3]), pk2(c1[0], c1[1]), pk2(c1[2], c1[3])};
                    const bf16x8 bfr = __builtin_bit_cast(bf16x8, bw);
#pragma unroll
                    for (int tt = 0; tt < 4; ++tt) {
                        const u32x2 x0 = xq[kp & 1][k2][tt][0], x1 = xq[kp & 1][k2][tt][1];
                        const bf16x8 afr = __builtin_bit_cast(bf16x8, (u32x4){x0.x, x0.y, x1.x, x1.y});
                        ao[tt] = __builtin_amdgcn_mfma_f32_16x16x32_bf16(afr, bfr, ao[tt], 0, 0, 0);
                    }
                }
                __builtin_amdgcn_sched_barrier(0);
            }
#undef LD_Q
#pragma unroll
            for (int tt = 0; tt < 4; ++tt) { const f32x4 wi = *(const LAS f32x4*)(sc + S_WI / 4 + 16 * tt + 4 * g); ao[tt] = ao[tt] * wi; }
            const int q = (lane & 15) >> 2, p = lane & 3;
            int va = VS + (8 * g + q) * VROW + (e0 + 4 * p) * 2, pa = PS + fr * PROW + 16 * g;
            asm volatile("" : "+v"(va), "+v"(pa));
#pragma unroll
            for (int ks = 0; ks < 2; ++ks) {
                const s16x4 v0 = tr_read(lds + va + ks * 32 * VROW);
                const s16x4 v1 = tr_read(lds + va + ks * 32 * VROW + 4 * VROW);
                const bf16x8 bfr = (bf16x8){v0[0], v0[1], v0[2], v0[3], v1[0], v1[1], v1[2], v1[3]};
#pragma unroll
                for (int tt = 0; tt < 4; ++tt) {
                    const bf16x8 afr = *(const LAS bf16x8*)(lds + pa + tt * 16 * PROW + 64 * ks);
                    ao[tt] = __builtin_amdgcn_mfma_f32_16x16x32_bf16(afr, bfr, ao[tt], 0, 0, 0);
                }
            }
            int hoff = 4 * g * DM + ecol + e0 + fr;
            int sco = (par * S_PAR) + 16 * g;
            asm volatile("" : "+v"(hoff), "+v"(sco));
            bf16_t* hp = (bf16_t*)(ws + WS_B0 + 2 * SZ1) + rbase * DM + hoff;
#pragma unroll
            for (int tt = 0; tt < 4; ++tt) {
                const LAS unsigned char* sb = lds + SC + sco + 64 * tt;
                const f32x4 wi = *(const LAS f32x4*)(sb + S_WI), qn = *(const LAS f32x4*)(sb + S_QN), r0 = *(const LAS f32x4*)(sb + S_RS0),
                            r1 = *(const LAS f32x4*)(sb + S_RS1), em = *(const LAS f32x4*)(sb + S_EMT);
#pragma unroll
                for (int jj = 0; jj < 4; ++jj) {
                    const float den = wi[jj] * qn[jj] + r0[jj] + r1[jj];
                    const float hv = ao[tt][jj] * rcpf_(fmaxf(fabsf(den), em[jj]));
                    hp[(size_t)(16 * tt + jj) * DM] = (bf16_t)(pk2(hv, 0.f) & 0xffffu);
                }
                __builtin_amdgcn_sched_barrier(0);
            }
        }
#endif
#ifndef NO_CU
        {
            const float dec = sc[S_DEC / 4];
            const int q = (lane & 15) >> 2, p = lane & 3;
            int vwa = VW + (8 * g + q) * VROW + (e0 + 4 * p) * 2, ka = KS + (8 * g + q) * QROW + 8 * p;
            asm volatile("" : "+v"(vwa), "+v"(ka));
            bf16x8 bw[2];
#pragma unroll
            for (int ks = 0; ks < 2; ++ks) {
                const s16x4 v0 = tr_read(lds + vwa + ks * 32 * VROW);
                const s16x4 v1 = tr_read(lds + vwa + ks * 32 * VROW + 4 * VROW);
                bw[ks] = (bf16x8){v0[0], v0[1], v0[2], v0[3], v1[0], v1[1], v1[2], v1[3]};
            }
            s16x4 kr[2][2][2][2];
#define LD_K(bi, gp) do { _Pragma("unroll") for (int d4 = 0; d4 < 2; ++d4) _Pragma("unroll") for (int ks = 0; ks < 2; ++ks) { \
                kr[bi][d4][ks][0] = tr_read(lds + ka + ks * 32 * QROW + (2 * (gp) + d4) * 32); kr[bi][d4][ks][1] = tr_read(lds + ka + ks * 32 * QROW + (2 * (gp) + d4) * 32 + 4 * QROW); } } while (0)
            LD_K(0, 0);
#pragma unroll
            for (int gp = 0; gp < 8; ++gp) {
                if (gp < 7) LD_K((gp + 1) & 1, gp + 1);
                __builtin_amdgcn_sched_barrier(0);
#pragma unroll
                for (int d4 = 0; d4 < 2; ++d4) {
                    const int dt = 2 * gp + d4;
                    accC[dt] = accC[dt] * dec;
#pragma unroll
                    for (int ks = 0; ks < 2; ++ks) {
                        const s16x4 k0 = kr[gp & 1][d4][ks][0], k1 = kr[gp & 1][d4][ks][1];
                        const bf16x8 afr = (bf16x8){k0[0], k0[1], k0[2], k0[3], k1[0], k1[1], k1[2], k1[3]};
                        accC[dt] = __builtin_amdgcn_mfma_f32_16x16x32_bf16(afr, bw[ks], accC[dt], 0, 0, 0);
                    }
                }
                __builtin_amdgcn_sched_barrier(0);
            }
#undef LD_K
            int tidN = tid; asm volatile("" : "+v"(tidN)); const int dn = tidN >> 1, sh2 = tidN & 1; float sn = 0.f;
#pragma unroll 8
            for (int s = 0; s < 32; ++s) { const int ss = 32 * sh2 + s; sn += sc[S_WS / 4 + ss] * bf1(*(const LAS bf16_t*)(lds + KS + ss * QROW + dn * 2)); }
            sn += __shfl_xor(sn, 1);
            if (sh2 == 0) nv[dn] = dec * nv[dn] + sn;
        }
#endif
    }
    __syncthreads();
    {
        float* Co = out + (sample ? O_SC : O_PC) + (size_t)(b * 4 + h) * 65536;
#pragma unroll
        for (int dt = 0; dt < 16; ++dt)
#pragma unroll
            for (int jj = 0; jj < 4; ++jj) Co[(size_t)(16 * dt + 4 * g + jj) * 256 + half * 128 + e0 + fr] = accC[dt][jj];
        if (half == 0) {
            if (tid < 256) out[(sample ? O_SN : O_PN) + (size_t)(b * 4 + h) * 256 + tid] = nv[tid];
            if (tid == 0) out[(sample ? O_SM : O_PM) + b * 4 + h] = mstate;
        }
    }
    __syncthreads();
}
}

namespace at {
constexpr int KB = 0, VB = 18432, TB = 55296, KROW = 144, VROWA = 288, VBUF = 64 * VROWA;
__device__ __forceinline__ void attn_unit(const Args& a, LAS unsigned char* lds, bool sample, int b, int h, int c0, int nch) {
    const int tid = threadIdx.x, lane = tid & 63, wid = __builtin_amdgcn_readfirstlane(tid >> 6), fr = lane & 15, g = lane >> 4;
    unsigned char* ws = a.ws;
    const bf16_t* AQ = (const bf16_t*)(ws + WS_B0 + 4 * SZ1); const bf16_t* AK = (const bf16_t*)(a.out + O_Y); const bf16_t* AV = AK + (size_t)TT * DM; bf16_t* AO = (bf16_t*)(ws + WS_B0 + 4 * SZ1);
    const bf16_t* CK = (const bf16_t*)(ws + WS_CK); const bf16_t* CV = (const bf16_t*)(ws + WS_CV);
    const int cw = c0 + (wid >> 1), qh = wid & 1; const bool active = (wid >> 1) < nch;
    const size_t qrow0 = sample ? (size_t)TP + b * DSEQ + 32 * qh : (size_t)b * SEQ + (size_t)cw * 64 + 32 * qh;
    LAS float* tbl = (LAS float*)(lds + TB);
    if (tid < 320) tbl[tid] = a.in[I_RELB][h * 257 + (tid < 256 ? tid : 256)] * 1.4426950408889634f;
    bf16x8 qf[2][2];
    if (active) {
#pragma unroll
        for (int tt = 0; tt < 2; ++tt)
#pragma unroll
            for (int ks = 0; ks < 2; ++ks) qf[tt][ks] = *(const bf16x8*)(AQ + (qrow0 + 16 * tt + fr) * DM + h * 64 + 32 * ks + 8 * g);
    }
    const int jlo = sample ? 0 : (c0 - 8 > 0 ? c0 - 8 : 0), jhi = sample ? 8 : c0 + nch - 1;
    const int lrow = tid >> 3, lch = (tid & 7) * 8;
    auto kv_src = [&](int j, const bf16_t*& kp, const bf16_t*& vp) {
        if (sample) { if (j < 8) { const size_t o = ((size_t)b * NPAST + j * 64 + lrow) * DM + h * 64 + lch; kp = CK + o; vp = CV + o; }
                      else { const size_t o = ((size_t)TP + b * DSEQ + lrow) * DM + h * 64 + lch; kp = AK + o; vp = AV + o; } }
        else { const size_t o = ((size_t)b * SEQ + (size_t)j * 64 + lrow) * DM + h * 64 + lch; kp = AK + o; vp = AV + o; }
    };
    u32x4 kreg, vreg;
    { const bf16_t *kp, *vp; kv_src(jlo, kp, vp); kreg = *(const u32x4*)kp; vreg = *(const u32x4*)vp; }
    *(LAS u32x4*)(lds + KB + lrow * KROW + lch * 2) = kreg; *(LAS u32x4*)(lds + VB + lrow * VROWA + lch * 2) = vreg;
    f32x4 o[4][2];
#pragma unroll
    for (int et = 0; et < 4; ++et) { o[et][0] = (f32x4){0.f, 0.f, 0.f, 0.f}; o[et][1] = (f32x4){0.f, 0.f, 0.f, 0.f}; }
    float mrun[2] = {-INFINITY, -INFINITY}, lsum[2] = {0.f, 0.f};
    __syncthreads();
    for (int j = jlo; j <= jhi; ++j) {
        const int buf = (j - jlo) & 1;
        if (j < jhi) { const bf16_t *kp, *vp; kv_src(j + 1, kp, vp); kreg = *(const u32x4*)kp; vreg = *(const u32x4*)vp; }
        const int dq = (sample ? 8 : cw) - j;
        if (active && dq >= 0 && dq <= 8) {
            const LAS unsigned char* kb = lds + KB + buf * 9216; const LAS unsigned char* vb = lds + VB + buf * VBUF;
            f32x4 s[4][2];
#pragma unroll
            for (int st = 0; st < 4; ++st) { s[st][0] = (f32x4){0.f, 0.f, 0.f, 0.f}; s[st][1] = (f32x4){0.f, 0.f, 0.f, 0.f}; }
#pragma unroll
            for (int ks = 0; ks < 2; ++ks)
#pragma unroll
                for (int st = 0; st < 4; ++st) {
                    const bf16x8 kf = *(const LAS bf16x8*)(kb + (16 * st + fr) * KROW + (32 * ks + 8 * g) * 2);
                    s[st][0] = __builtin_amdgcn_mfma_f32_16x16x32_bf16(kf, qf[0][ks], s[st][0], 0, 0, 0);
                    s[st][1] = __builtin_amdgcn_mfma_f32_16x16x32_bf16(kf, qf[1][ks], s[st][1], 0, 0, 0);
                }
            const float bfar = tbl[256];
            constexpr float SC2 = 0.125f * 1.4426950408889634f;
            if (dq < 3) {
                const int relb = 64 * dq + 32 * qh + fr - 4 * g + 128;
#pragma unroll
                for (int tt = 0; tt < 2; ++tt)
#pragma unroll
                    for (int st = 0; st < 4; ++st)
#pragma unroll
                        for (int jj = 0; jj < 4; ++jj) s[st][tt][jj] = __builtin_fmaf(s[st][tt][jj], SC2, tbl[relb + 16 * tt - 16 * st - jj]);
            } else {
#pragma unroll
                for (int tt = 0; tt < 2; ++tt)
#pragma unroll
                    for (int st = 0; st < 4; ++st) s[st][tt] = s[st][tt] * SC2 + bfar;
            }
#pragma unroll
            for (int tt = 0; tt < 2; ++tt) {
                float mx = fmaxf(fmaxf(s[0][tt][0], s[0][tt][1]), fmaxf(s[0][tt][2], s[0][tt][3]));
#pragma unroll
                for (int st = 1; st < 4; ++st) mx = fmaxf(fmaxf(mx, s[st][tt][0]), fmaxf(fmaxf(s[st][tt][1], s[st][tt][2]), s[st][tt][3]));
                mx = fmaxf(mx, __shfl_xor(mx, 16)); mx = fmaxf(mx, __shfl_xor(mx, 32));
                const float mnew = fmaxf(mrun[tt], mx), alpha = __builtin_amdgcn_exp2f(mrun[tt] - mnew);
                const bool chg = mnew > mrun[tt]; mrun[tt] = mnew;
                f32x4 psv = (f32x4){0.f, 0.f, 0.f, 0.f}; const float nmn = -mnew; const f32x4 nm4 = (f32x4){nmn, nmn, nmn, nmn};
#pragma unroll
                for (int st = 0; st < 4; ++st) {
                    const f32x4 d = s[st][tt] + nm4;
                    const f32x4 pv4 = (f32x4){__builtin_amdgcn_exp2f(d[0]), __builtin_amdgcn_exp2f(d[1]), __builtin_amdgcn_exp2f(d[2]), __builtin_amdgcn_exp2f(d[3])};
                    s[st][tt] = pv4; psv = psv + pv4;
                }
                lsum[tt] = lsum[tt] * alpha + ((psv[0] + psv[1]) + (psv[2] + psv[3]));
                if (__any(chg)) {
#pragma unroll
                    for (int et = 0; et < 4; ++et) o[et][tt] = o[et][tt] * alpha;
                }
            }
            const int q = (lane & 15) >> 2, p = lane & 3;
#pragma unroll
            for (int ks2 = 0; ks2 < 2; ++ks2) {
                bf16x8 pf[2];
#pragma unroll
                for (int tt = 0; tt < 2; ++tt) { const f32x4 p0 = s[2 * ks2][tt], p1 = s[2 * ks2 + 1][tt];
                    pf[tt] = __builtin_bit_cast(bf16x8, (u32x4){pk2(p0[0], p0[1]), pk2(p0[2], p0[3]), pk2(p1[0], p1[1]), pk2(p1[2], p1[3])}); }
#pragma unroll
                for (int et = 0; et < 4; ++et) {
                    const s16x4 v0 = tr_read(vb + (32 * ks2 + 4 * g + q) * VROWA + (16 * et + 4 * p) * 2);
                    const s16x4 v1 = tr_read(vb + (32 * ks2 + 16 + 4 * g + q) * VROWA + (16 * et + 4 * p) * 2);
                    const bf16x8 vf = (bf16x8){v0[0], v0[1], v0[2], v0[3], v1[0], v1[1], v1[2], v1[3]};
                    o[et][0] = __builtin_amdgcn_mfma_f32_16x16x32_bf16(vf, pf[0], o[et][0], 0, 0, 0);
                    o[et][1] = __builtin_amdgcn_mfma_f32_16x16x32_bf16(vf, pf[1], o[et][1], 0, 0, 0);
                }
            }
        }
        if (j < jhi) { *(LAS u32x4*)(lds + KB + (buf ^ 1) * 9216 + lrow * KROW + lch * 2) = kreg; *(LAS u32x4*)(lds + VB + (buf ^ 1) * VBUF + lrow * VROWA + lch * 2) = vreg; }
        __syncthreads();
    }
    if (active) {
#pragma unroll
        for (int tt = 0; tt < 2; ++tt) {
            float l = lsum[tt]; l += __shfl_xor(l, 16); l += __shfl_xor(l, 32);
            const float inv = 1.f / l;
#pragma unroll
            for (int et = 0; et < 4; ++et) {
                const f32x4 v = o[et][tt] * inv;
                *(u32x2*)(AO + (qrow0 + 16 * tt + fr) * DM + h * 64 + 16 * et + 4 * g) = (u32x2){pk2(v[0], v[1]), pk2(v[2], v[3])};
            }
        }
    }
}
}

constexpr int NPHASE = 14;
__global__ void __launch_bounds__(512, 2) mega_fwd(Args args) {
    extern __shared__ __attribute__((aligned(16))) unsigned char lds_raw[];
    LAS unsigned char* lds = (LAS unsigned char*)lds_raw;
    unsigned char* ws = args.ws;
    float* U = args.out + O_Y;
    bf16_t* HB = (bf16_t*)(ws + WS_HB);
    bf16_t* UB = (bf16_t*)(ws + WS_B0 + 3 * SZ1);
    bf16_t* ACT = (bf16_t*)(ws + WS_ACT);
    const int lo = args.ph_lo, hi = args.ph_hi;
    const int G = gridDim.x, blk = blockIdx.x;
#ifndef PH_MASK
#define PH_MASK 0xFFFF
#endif
#define IN(k) (((PH_MASK >> (k)) & 1) && lo <= (k) && (k) < hi)
#ifndef DUP_MASK
#define DUP_MASK 0
#endif
#define REP(k) for (int rep_ = 0; rep_ < 1 + ((DUP_MASK >> (k)) & 1); ++rep_)
    volatile LAS unsigned* bst = (volatile LAS unsigned*)(lds + LDS_BYTES - 64);
    if (threadIdx.x < 2) bst[threadIdx.x] = 0u;
    __syncthreads();
    if (hi - lo > 1) (void)xcd_barrier_post((unsigned*)(ws + WS_BAR), bst);
#define SEAM(k) do { if (IN(k) && IN((k) + 1)) { if ((k) == 0) cg::this_grid().sync(); else xcd_barrier((unsigned*)(args.ws + WS_BAR), (volatile LAS unsigned*)(lds + LDS_BYTES - 64)); } } while (0)

    if (IN(0)) { p0_prologue(args, lds); if (DUP_MASK & 1) { __syncthreads(); p0_prologue(args, lds); } }
    SEAM(0);
    if (IN(1)) {
        pg8::Gemm g{}; g.A[0] = HB; g.Bt[0] = (const bf16_t*)(ws + WS_WGU1); g.M = TT; g.N = 2 * FF; g.K = DM;
        pg8::StaticOrder S; S.init(TT, 2 * FF, G, blk, 1);
        pg8::EpiSwiglu E{ACT};
        pg8::gemm_phase(lds, g, S, E);
        if ((DUP_MASK >> 1) & 1) pg8::gemm_phase(lds, g, S, E);
    }
    SEAM(1);
    if (IN(2)) {
        pg8::Gemm g{}; g.A[0] = ACT; g.Bt[0] = (const bf16_t*)(ws + WS_WD1); g.M = TT; g.N = DM; g.K = FF;
        pg8::StaticOrder S; S.init(TP, DM, G, blk, 1);
        pg8::EpiResid E{UB, nullptr, nullptr, HB, 0.5f, 1};
        pg8::gemm_phase(lds, g, S, E);
    }
    SEAM(2);
    if (IN(3)) {
        if (blk < 16) {
            pg8::Gemm g{}; g.A[0] = ACT; g.Bt[0] = (const bf16_t*)(ws + WS_WD1); g.M = TT; g.N = DM; g.K = FF;
            pg8::StaticOrder S; S.init(TS, DM, G, blk, 1, TP / 256);
            pg8::EpiResid E{UB, nullptr, nullptr, HB, 0.5f, 1};
            pg8::gemm_phase(lds, g, S, E);
        } else {
            ln_pass<1>(UB, nullptr, HB, args.in[I_LN1G], args.in[I_LN1B], (const float*)(ws + WS_WIF), (float*)(ws + WS_IF), 0, TP, 16, G - 16);
        }
        xcd_barrier((unsigned*)(args.ws + WS_BAR), (volatile LAS unsigned*)(lds + LDS_BYTES - 64));
        ln_pass<1>(UB, nullptr, HB, args.in[I_LN1G], args.in[I_LN1B], (const float*)(ws + WS_WIF), (float*)(ws + WS_IF), TP, TT, 0, G);
    }
    SEAM(3);
    if (IN(4)) {
        pg8::Gemm g{}; g.A[0] = HB; g.Bt[0] = (const bf16_t*)(ws + WS_WML); g.M = TT; g.N = 7168; g.K = DM;
        pg8::StaticOrder S; S.init(TT, 7168, G, blk, 1);
        pg8::EpiSplitBf16 E{}; for (int i = 0; i < 5; ++i) E.dst[i] = (bf16_t*)(ws + WS_B0 + i * SZ1); E.dst[5] = (bf16_t*)U; E.dst[6] = (bf16_t*)U + (size_t)TT * DM;
        E.pk = args.out + O_PK; E.sk = args.out + O_SK; E.pv = args.out + O_PV; E.sv = args.out + O_SV; E.kt = 5; E.vt = 6;
        pg8::gemm_phase(lds, g, S, E);
    }
    SEAM(4);
    if (IN(5)) {
        for (int it = blk; it < 384; it += G) {
            int item = it;
            if (G == 256) {
                if (it < 256) { const int x = it & 7, j = it >> 3; item = ((x * 16 + (j >> 1)) << 1) | (j & 1); }
                else { const int sidx = it - 256, x = sidx & 7, j = sidx >> 3; item = 256 + (((x * 8 + (j >> 1)) << 1) | (j & 1)); }
            }
            ml::mlstm_item(args, lds, item);
        }
    }
    SEAM(5);
    if (IN(6)) {
        headln_pass((bf16_t*)(ws + WS_B0 + 2 * SZ1), (const bf16_t*)(ws + WS_B0 + 3 * SZ1), args.in[I_MLNG]);
    }
    if (IN(7)) {
        for (int u = blk; u < 4096 + 256; u += G) {
            if (u < 4096) { const int i = u >> 8, bb = u & 255, quad = i & 7, bh = (i >> 3) * 256 + bb; at::attn_unit(args, lds, false, bh >> 4, bh & 15, quad * 4, 4); }
            else { const int s = u - 4096; at::attn_unit(args, lds, true, s >> 4, s & 15, 8, 1); }
        }
    }
    SEAM(7);
    if (IN(8)) {
        pg8::Gemm g{}; g.A[0] = HB; g.A[1] = (const bf16_t*)(ws + WS_B0 + 2 * SZ1); g.A[2] = HB; g.A[3] = (const bf16_t*)(ws + WS_B0 + 4 * SZ1);
        g.Bt[0] = (const bf16_t*)(ws + WS_WGM); g.Bt[1] = (const bf16_t*)(ws + WS_WMLP); g.Bt[2] = (const bf16_t*)(ws + WS_WGA); g.Bt[3] = (const bf16_t*)(ws + WS_WATTP);
        g.M = TT; g.N = DM; g.K = DM;
        pg8::StaticOrder S; S.init(TP, DM, G, blk, 4);
        pg8::EpiMerge E{(bf16_t*)(ws + WS_B0), (u32x4*)(ws + WS_GSCR) + (size_t)blk * 48 * 512};
        pg8::gemm_phase(lds, g, S, E);
    }
    SEAM(8);
    if (IN(9)) {
        if (blk < 16) {
            pg8::Gemm g{}; g.A[0] = HB; g.A[1] = (const bf16_t*)(ws + WS_B0 + 2 * SZ1); g.A[2] = HB; g.A[3] = (const bf16_t*)(ws + WS_B0 + 4 * SZ1);
            g.Bt[0] = (const bf16_t*)(ws + WS_WGM); g.Bt[1] = (const bf16_t*)(ws + WS_WMLP); g.Bt[2] = (const bf16_t*)(ws + WS_WGA); g.Bt[3] = (const bf16_t*)(ws + WS_WATTP);
            g.M = TT; g.N = DM; g.K = DM;
            pg8::StaticOrder S; S.init(TS, DM, G, blk, 4, TP / 256);
            pg8::EpiMerge E{(bf16_t*)(ws + WS_B0), (u32x4*)(ws + WS_GSCR) + (size_t)blk * 48 * 512};
            pg8::gemm_phase(lds, g, S, E);
        } else {
            pg8::Gemm g{}; g.A[0] = (const bf16_t*)(ws + WS_B0); g.Bt[0] = (const bf16_t*)(ws + WS_WOUT); g.M = TT; g.N = DM; g.K = DM;
            pg8::StaticOrder S; S.init(TP, DM, G - 16, blk - 16, 1);
            pg8::EpiResid E{UB, nullptr, nullptr, HB, 1.0f, 1};
            pg8::gemm_phase(lds, g, S, E);
        }
    }
    SEAM(9);
    if (IN(10)) {
        if (blk < 16) {
            pg8::Gemm g{}; g.A[0] = (const bf16_t*)(ws + WS_B0); g.Bt[0] = (const bf16_t*)(ws + WS_WOUT); g.M = TT; g.N = DM; g.K = DM;
            pg8::StaticOrder S; S.init(TS, DM, G, blk, 1, TP / 256);
            pg8::EpiResid E{UB, nullptr, nullptr, HB, 1.0f, 1};
            pg8::gemm_phase(lds, g, S, E);
        } else {
            ln_pass<2>(UB, nullptr, HB, args.in[I_LN2G], args.in[I_LN2B], nullptr, nullptr, 0, TP, 16, G - 16);
        }
        xcd_barrier((unsigned*)(args.ws + WS_BAR), (volatile LAS unsigned*)(lds + LDS_BYTES - 64));
        ln_pass<2>(UB, nullptr, HB, args.in[I_LN2G], args.in[I_LN2B], nullptr, nullptr, TP, TT, 0, G);
    }
    SEAM(10);
    if (IN(11)) {
        pg8::Gemm g{}; g.A[0] = HB; g.Bt[0] = (const bf16_t*)(ws + WS_WGU2); g.M = TT; g.N = 2 * FF; g.K = DM;
        pg8::StaticOrder S; S.init(TT, 2 * FF, G, blk, 1);
        pg8::EpiSwiglu E{ACT};
        pg8::gemm_phase(lds, g, S, E);
        if ((DUP_MASK >> 11) & 1) pg8::gemm_phase(lds, g, S, E);
    }
    SEAM(11);
    if (IN(12)) {
        pg8::Gemm g{}; g.A[0] = ACT; g.Bt[0] = (const bf16_t*)(ws + WS_WD2); g.M = TT; g.N = DM; g.K = FF;
        pg8::StaticOrder S; S.init(TP, DM, G, blk, 1);
        pg8::EpiResid E{UB, nullptr, nullptr, HB, 0.5f, 1};
        pg8::gemm_phase(lds, g, S, E);
    }
    SEAM(12);
    if (IN(13)) {
        if (blk < 16) {
            pg8::Gemm g{}; g.A[0] = ACT; g.Bt[0] = (const bf16_t*)(ws + WS_WD2); g.M = TT; g.N = DM; g.K = FF;
            pg8::StaticOrder S; S.init(TS, DM, G, blk, 1, TP / 256);
            pg8::EpiResid E{UB, nullptr, nullptr, HB, 0.5f, 1};
            pg8::gemm_phase(lds, g, S, E);
        } else {
            ln_pass<3>(UB, U, nullptr, args.in[I_LN3G], args.in[I_LN3B], nullptr, nullptr, 0, TP, 16, G - 16);
        }
        xcd_barrier((unsigned*)(args.ws + WS_BAR), (volatile LAS unsigned*)(lds + LDS_BYTES - 64));
        ln_pass<3>(UB, U, nullptr, args.in[I_LN3G], args.in[I_LN3B], nullptr, nullptr, TP, TT, 0, G);
    }
#undef IN
#undef SEAM
}

extern "C" void kernel_launch(void* const* d_in, const int* in_sizes, int n_in, void* d_out, int out_size, void* d_ws, size_t ws_size, hipStream_t stream) {
    static int grid = 0;
    if (grid == 0) {
        if (n_in != 28 || ws_size < WS_END || (size_t)out_size != O_END) {
            fprintf(stderr, "kernel_launch: unexpected sizes n_in %d ws %zu (need %zu) out %d (expect %zu)\n", n_in, ws_size, (size_t)WS_END, out_size, (size_t)O_END);
            if (n_in != 28 || ws_size < WS_END) { grid = -1; return; }
        }
        (void)hipFuncSetAttribute((const void*)mega_fwd, hipFuncAttributeMaxDynamicSharedMemorySize, LDS_BYTES);
        int dev = 0, cus = 0, per_cu = 0;
        (void)hipGetDevice(&dev); (void)hipDeviceGetAttribute(&cus, hipDeviceAttributeMultiprocessorCount, dev);
        (void)hipOccupancyMaxActiveBlocksPerMultiprocessor(&per_cu, (const void*)mega_fwd, 512, LDS_BYTES);
        if (per_cu < 1) fprintf(stderr, "kernel_launch: occupancy query says %d blocks/CU\n", per_cu);
        (void)hipGetLastError();
        grid = cus > 0 ? cus : 256;
    }
    if (grid < 0) return;
    Args a{};
    for (int i = 0; i < 28; ++i) a.in[i] = (const float*)d_in[i];
    a.out = (float*)d_out; a.ws = (unsigned char*)d_ws;
#if MK_ONE_LAUNCH
    (void)hipMemsetAsync((char*)d_ws + WS_BAR, 0, 16384, stream);
    a.ph_lo = 0; a.ph_hi = NPHASE;
    void* kargs[] = {&a};
    hipError_t e = hipLaunchCooperativeKernel((const void*)mega_fwd, dim3(grid), dim3(512), kargs, LDS_BYTES, stream);
    if (e != hipSuccess) fprintf(stderr, "cooperative launch failed: %s (grid %d)\n", hipGetErrorString(e), grid);
#else
    for (int p = 0; p < NPHASE; ++p) { a.ph_lo = p; a.ph_hi = p + 1; hipLaunchKernelGGL(mega_fwd, dim3(grid), dim3(512), LDS_BYTES, stream, a); }
#endif
}
```

```cpp
#include <hip/hip_runtime.h>
#include <hip/hip_cooperative_groups.h>
#include <cstdio>
#include <cstdint>
namespace cg = cooperative_groups;

#ifndef MK_ONE_LAUNCH
#define MK_ONE_LAUNCH 1
#endif

#define LAS __attribute__((address_space(3)))
typedef unsigned short bf16_t;
typedef short bf16x8 __attribute__((ext_vector_type(8)));
typedef short s16x4 __attribute__((ext_vector_type(4)));
typedef float f32x4 __attribute__((ext_vector_type(4)));
typedef unsigned u32x4 __attribute__((ext_vector_type(4)));
typedef unsigned u32x2 __attribute__((ext_vector_type(2)));

constexpr int DM = 1024, TP = 65536, TS = 1024, TT = TP + TS, FF = 2816, SEQ = 2048, NB = 32, NSB = 16, DSEQ = 64, NPAST = 512;
constexpr int INW = 9224;
constexpr float ALPHA = 1.189207115002721f;
constexpr float LN_EPS = 1e-5f;
constexpr size_t MiB = 1u << 20;
constexpr size_t SZ1 = (size_t)TT * DM * 2;
constexpr size_t WS_WGU1 = 0, WS_WD1 = 11 * MiB, WS_WGU2 = 17 * MiB, WS_WD2 = 28 * MiB, WS_WML = 34 * MiB, WS_WATT = 42 * MiB,
                 WS_WGM = 48 * MiB, WS_WGA = 50 * MiB, WS_WMLP = 52 * MiB, WS_WATTP = 54 * MiB, WS_WOUT = 56 * MiB, WS_WIF = 58 * MiB, WS_IF = 59 * MiB, WS_BAR = 63 * MiB;
constexpr size_t WS_HB = 64 * MiB;
constexpr size_t WS_ACT = 194 * MiB;
constexpr size_t WS_B0 = 194 * MiB;
constexpr size_t WS_CK = WS_B0 + 5 * SZ1, WS_CV = WS_CK + 16 * MiB, WS_GSCR = WS_CV + 16 * MiB, WS_END = WS_GSCR + 96 * MiB;
static_assert(WS_END <= 1024 * MiB, "ws map");
constexpr size_t O_Y = 0, O_PCONV = (size_t)TT * DM, O_SCONV = O_PCONV + 32 * 3 * 2048, O_PC = O_SCONV + 16 * 3 * 2048, O_SC = O_PC + (size_t)32 * 4 * 65536,
                 O_PN = O_SC + (size_t)16 * 4 * 65536, O_SN = O_PN + 32 * 4 * 256, O_PM = O_SN + 16 * 4 * 256, O_SM = O_PM + 128, O_PK = O_SM + 64,
                 O_SK = O_PK + (size_t)32 * 512 * 1024, O_PV = O_SK + (size_t)16 * 64 * 1024, O_SV = O_PV + (size_t)32 * 512 * 1024, O_END = O_SV + (size_t)16 * 64 * 1024;

constexpr int LDS_BYTES = 147456;

__device__ __forceinline__ unsigned pk2(float lo, float hi) { unsigned r; asm volatile("v_cvt_pk_bf16_f32 %0, %1, %2" : "=v"(r) : "v"(lo), "v"(hi)); return r; }
__device__ __forceinline__ float bflo(unsigned w) { return __uint_as_float(w << 16); }
__device__ __forceinline__ float bfhi(unsigned w) { return __uint_as_float(w & 0xffff0000u); }
__device__ __forceinline__ float bf1(bf16_t b) { return __uint_as_float(((unsigned)b) << 16); }
__device__ __forceinline__ float rcpf_(float x) { return __builtin_amdgcn_rcpf(x); }
__device__ __forceinline__ float sigmoidf_(float x) { return __builtin_amdgcn_rcpf(1.0f + __expf(-x)); }
__device__ __forceinline__ float wave_sum(float v) {
#pragma unroll
    for (int o = 1; o < 64; o <<= 1) v += __shfl_xor(v, o);
    return v;
}
__device__ __forceinline__ s16x4 tr_read(const LAS unsigned char* p) {
    typedef short v4i16_t __attribute__((ext_vector_type(4)));
    return __builtin_bit_cast(s16x4, __builtin_amdgcn_ds_read_tr16_b64_v4i16((LAS v4i16_t*)p));
}


#define XB_TMO      128
#define XB_XCNT(j)  (256  + 64 * (j))
#define XB_XSUB(j)  (1280 + 64 * (j))
#define XB_XGEN(j)  (2304 + 64 * (j))
#define XB_TOP      3328
#define XB_TOPGEN   3392
#define XCD_BAR_WORDS 3456
#define XB_SPIN_CAP (1u << 22)
__device__ __forceinline__ unsigned xb_ld(unsigned* p)              { return __hip_atomic_load(p, __ATOMIC_RELAXED, __HIP_MEMORY_SCOPE_AGENT); }
__device__ __forceinline__ unsigned xb_add(unsigned* p, unsigned v) { return __hip_atomic_fetch_add(p, v, __ATOMIC_RELAXED, __HIP_MEMORY_SCOPE_AGENT); }
__device__ __forceinline__ unsigned xb_xcc_id() { return (unsigned)__builtin_amdgcn_s_getreg((3 << 11) | 20) & 0xFu; }
#define XB_SPIN(cond, bar) do { unsigned _sp = 0; while (cond) { __builtin_amdgcn_s_sleep(1); \
    if ((++_sp & 255u) == 0u) { if (xb_ld(&(bar)[XB_TMO])) break; if (_sp > XB_SPIN_CAP) { atomicAdd(&(bar)[XB_TMO], 1u); break; } } } } while (0)
struct XcdBarrier { unsigned* bar; unsigned x; volatile LAS unsigned* st; };
__device__ __forceinline__ XcdBarrier xcd_barrier_post(unsigned* bar, volatile LAS unsigned* st) {
    XcdBarrier b; b.bar = bar; b.x = xb_xcc_id(); b.st = st;
    if (threadIdx.x == 0) (void)xb_add(&bar[XB_XCNT(b.x)], 1u);
    return b;
}
__device__ __forceinline__ void xcd_barrier_complete(unsigned* bar, unsigned x, unsigned& nloc, unsigned& nx) {
    const unsigned G = gridDim.x * gridDim.y * gridDim.z;
    unsigned sum, cnt, mine, sp = 0u;
    for (;;) {
        sum = 0u; cnt = 0u; mine = 0u;
#pragma unroll
        for (unsigned j = 0; j < 16; ++j) { const unsigned c = xb_ld(&bar[XB_XCNT(j)]); sum += c; cnt += (c > 0u) ? 1u : 0u; mine = (j == x) ? c : mine; }
        if (sum == G) break;
        __builtin_amdgcn_s_sleep(1);
        if ((++sp & 255u) == 0u) { if (xb_ld(&bar[XB_TMO])) break; if (sp > XB_SPIN_CAP) { atomicAdd(&bar[XB_TMO], 1u); break; } }
    }
    nloc = mine > 0u ? mine : 1u; nx = cnt > 0u ? cnt : 1u;
}
__device__ __forceinline__ void xcd_barrier(unsigned* bar_, volatile LAS unsigned* st_) {
    XcdBarrier b; b.bar = bar_; b.st = st_; b.x = xb_xcc_id();
    asm volatile("s_waitcnt vmcnt(0)" ::: "memory");
    __syncthreads();
    if (threadIdx.x == 0) {
        unsigned* bar = b.bar;
        __builtin_amdgcn_s_waitcnt(0);
        unsigned nloc = b.st[0], nx = b.st[1];
        if (nloc == 0u) { xcd_barrier_complete(bar, b.x, nloc, nx); b.st[0] = nloc; b.st[1] = nx; }
        const unsigned old = xb_add(&bar[XB_XSUB(b.x)], 1u);
        const unsigned gen = old / nloc;
        if (old + 1u == (gen + 1u) * nloc) {
            __builtin_amdgcn_fence(__ATOMIC_RELEASE, "agent");
            asm volatile("s_waitcnt vmcnt(0)" ::: "memory");
            const unsigned og = xb_add(&bar[XB_TOP], 1u);
            const unsigned tg = og / nx;
            if (og + 1u == (tg + 1u) * nx) xb_add(&bar[XB_TOPGEN], 1u);
            else XB_SPIN(xb_ld(&bar[XB_TOPGEN]) == tg, bar);
            __builtin_amdgcn_fence(__ATOMIC_ACQUIRE, "agent");
            xb_add(&bar[XB_XGEN(b.x)], 1u);
            asm volatile("s_waitcnt vmcnt(0)" ::: "memory");
        } else {
            XB_SPIN(xb_ld(&bar[XB_XGEN(b.x)]) == gen, bar);
            __builtin_amdgcn_fence(__ATOMIC_ACQUIRE, "agent");
            asm volatile("s_waitcnt vmcnt(0)" ::: "memory");
        }
    }
    __syncthreads();
}

namespace pg8 {
constexpr int BM = 256, BK = 64, HALF = 128, HTB = HALF * BK * 2, STAGE_BYTES = 8 * HTB, NXCD = 8, WGM = 8;
__host__ __device__ __forceinline__ int lds_byte(int r, int c) { const int st = (r >> 4) * 2 + (c >> 5), rr = r & 15, cc = c & 31, ob = rr * 64 + cc * 2; return st * 1024 + (ob ^ (((ob >> 9) & 1) << 5)); }
__host__ __device__ __forceinline__ void stage_rc(int b, int& R, int& C) { const int st = b / 1024, sb = b % 1024, swz = sb ^ (((sb >> 9) & 1) << 5); R = (st >> 1) * 16 + swz / 64; C = (st & 1) * 32 + (swz % 64) / 2; }
__host__ __device__ __forceinline__ int perm32(int rho) { const int n = rho >> 4, i = rho & 15; return 8 * (i >> 2) + 4 * n + (i & 3); }

struct Unit { int pm, pn, seg; };
struct Gemm { const bf16_t* A[4]; const bf16_t* Bt[4]; int M, N, K;
    __device__ __forceinline__ const char* a(int sg) const { return (const char*)(sg == 0 ? A[0] : sg == 1 ? A[1] : sg == 2 ? A[2] : A[3]); }
    __device__ __forceinline__ const char* b(int sg) const { return (const char*)(sg == 0 ? Bt[0] : sg == 1 ? Bt[1] : sg == 2 ? Bt[2] : Bt[3]); } };

struct StaticOrder {
    int nM, nN, nwg, G, c, nseg, pm_off;
    __device__ void init(int M, int N, int G_, int c_, int nseg_, int pm_off_ = 0) { nM = M / BM; nN = N / BM; nwg = nM * nN; G = G_; c = c_; nseg = nseg_; pm_off = pm_off_; }
    __device__ bool next(int ii, Unit& u) const {
        const int i = ii / nseg; u.seg = ii - i * nseg;
        const long L = (long)i * G + c; if (L >= nwg) return false;
        int wgid = (int)L; { const int q = nwg / NXCD, r = nwg % NXCD, xcd = wgid % NXCD, off = wgid / NXCD; wgid = (xcd < r ? xcd * (q + 1) : r * (q + 1) + (xcd - r) * q) + off; }
        const int nig = WGM * nN, gid = wgid / nig, fm = gid * WGM, gsz = (nM - fm) < WGM ? (nM - fm) : WGM;
        u.pm = pm_off + fm + ((wgid % nig) % gsz); u.pn = (wgid % nig) / gsz; return true;
    }
};

template <class Epi, class Sched>
__device__ __forceinline__ void gemm_phase(LAS unsigned char* lds, const Gemm g, const Sched& S, const Epi& E) {
    const int tid = threadIdx.x, wid = __builtin_amdgcn_readfirstlane(tid >> 6), lane = tid & 63, wr = wid >> 2, wc = wid & 3, fr = lane & 15, fq = lane >> 4;
    const int K = g.K, nt = K / BK;
    unsigned voffA[2], voffB[2];
#pragma unroll
    for (int i = 0; i < 2; ++i) { int R, C; stage_rc(tid * 16 + i * 8192, R, C); const int Rb = Epi::PERM ? ((R & ~31) + perm32(R & 31)) : R;
        voffA[i] = (unsigned)(R * K + C) * 2u; voffB[i] = (unsigned)(Rb * K + C) * 2u; }
    const size_t kstep = (size_t)(BK * 2);
    const size_t hstep = (size_t)HALF * K * 2;
    const size_t tstep = 2 * hstep;
    const unsigned ldsw = (unsigned)wid * 1024u;
    const int aoff = lds_byte(wr * 64 + fr, fq * 8), boff = lds_byte(wc * 32 + fr, fq * 8);
#define PG8_SA(b, h) (((b) * 2 + (h)) * HTB)
#define PG8_SB(b, h) ((4 + (b) * 2 + (h)) * HTB)
#define PG8_STAGE(bufoff, gbase, voff) do { _Pragma("unroll") for (int _i = 0; _i < 2; ++_i) \
        __builtin_amdgcn_global_load_lds((const unsigned*)((const char*)(gbase) + (voff)[_i]), (LAS unsigned*)(lds + (bufoff) + ldsw + _i * 8192), 16, 0, 0); } while (0)
#define PG8_LDA(dst, b, h) do { _Pragma("unroll") for (int m = 0; m < 4; ++m) _Pragma("unroll") for (int k = 0; k < 2; ++k) dst[m][k] = *(const LAS bf16x8*)(lds + PG8_SA(b, h) + aoff + m * 2048 + k * 1024); } while (0)
#define PG8_LDB(dst, b, h) do { _Pragma("unroll") for (int n = 0; n < 2; ++n) _Pragma("unroll") for (int k = 0; k < 2; ++k) dst[n][k] = *(const LAS bf16x8*)(lds + PG8_SB(b, h) + boff + n * 2048 + k * 1024); } while (0)
#define PG8_MMA(ai, bj, At, Bt) do { __builtin_amdgcn_s_setprio(1); _Pragma("unroll") for (int m = 0; m < 4; ++m) _Pragma("unroll") for (int n = 0; n < 2; ++n) _Pragma("unroll") for (int k = 0; k < 2; ++k) \
        acc[ai][bj][m][n] = __builtin_amdgcn_mfma_f32_16x16x32_bf16(Bt[n][k], At[m][k], acc[ai][bj][m][n], 0, 0, 0); __builtin_amdgcn_s_setprio(0); } while (0)
#define PG8_WAIT_V(n) asm volatile("s_waitcnt vmcnt(" #n ")" ::: "memory")
#define PG8_WAIT_L(n) asm volatile("s_waitcnt lgkmcnt(" #n ")" ::: "memory")
#define PG8_BAR __builtin_amdgcn_s_barrier()
#define PG8_SCHED __builtin_amdgcn_sched_barrier(0)
    Unit cur, nxt; int ui = 0;
    if (!S.next(0, cur)) return;
    f32x4 acc[2][2][4][2];
#pragma unroll
    for (int a = 0; a < 2; ++a)
#pragma unroll
        for (int b = 0; b < 2; ++b)
#pragma unroll
            for (int m = 0; m < 4; ++m)
#pragma unroll
                for (int n = 0; n < 2; ++n) acc[a][b][m][n] = (f32x4){0.f, 0.f, 0.f, 0.f};
    bf16x8 At[4][2], B0[2][2], B1[2][2];
    const char* cA = g.a(cur.seg) + (size_t)cur.pm * tstep; const char* cB = g.b(cur.seg) + (size_t)cur.pn * tstep;
    PG8_STAGE(PG8_SB(0, 0), cB, voffB); PG8_STAGE(PG8_SB(0, 1), cB + hstep, voffB); PG8_STAGE(PG8_SA(0, 0), cA, voffA); PG8_STAGE(PG8_SA(0, 1), cA + hstep, voffA);
    if (wr == 1) PG8_BAR;
    PG8_WAIT_V(2); PG8_BAR;
    PG8_STAGE(PG8_SB(1, 0), cB + kstep, voffB); PG8_STAGE(PG8_SA(1, 0), cA + kstep, voffA); PG8_STAGE(PG8_SB(1, 1), cB + hstep + kstep, voffB);
    PG8_WAIT_V(6); PG8_BAR;
    for (;;) {
        const bool has_next = S.next(ui + 1, nxt);
        const char* nA = has_next ? g.a(nxt.seg) + (size_t)nxt.pm * tstep : cA; const char* nB = has_next ? g.b(nxt.seg) + (size_t)nxt.pn * tstep : cB;
        for (int t = 0; t < nt; t += 2) {
            const bool last = (t == nt - 2);
            const char* a1 = cA + (size_t)(t + 1) * kstep;
            const char* a2 = last ? nA : cA + (size_t)(t + 2) * kstep; const char* b2 = last ? nB : cB + (size_t)(t + 2) * kstep;
            const char* a3 = a2 + kstep; const char* b3 = b2 + kstep;
            PG8_LDB(B0, 0, 0); PG8_LDB(B1, 0, 1); PG8_SCHED; PG8_LDA(At, 0, 0); PG8_STAGE(PG8_SA(1, 1), a1 + hstep, voffA);
            PG8_WAIT_V(8); PG8_WAIT_L(0); PG8_BAR; PG8_MMA(0, 0, At, B0); PG8_MMA(0, 1, At, B1); PG8_BAR; PG8_SCHED;
            PG8_LDA(At, 0, 1); PG8_STAGE(PG8_SB(0, 0), b2, voffB); PG8_STAGE(PG8_SB(0, 1), b2 + hstep, voffB); PG8_STAGE(PG8_SA(0, 0), a2, voffA);
            PG8_WAIT_V(8); PG8_WAIT_L(0); PG8_BAR; PG8_MMA(1, 0, At, B0); PG8_MMA(1, 1, At, B1); PG8_BAR; PG8_SCHED;
            PG8_LDB(B0, 1, 0); PG8_LDB(B1, 1, 1); PG8_SCHED; PG8_LDA(At, 1, 0); PG8_STAGE(PG8_SA(0, 1), a2 + hstep, voffA);
            PG8_WAIT_V(8); PG8_WAIT_L(0); PG8_BAR; PG8_MMA(0, 0, At, B0); PG8_MMA(0, 1, At, B1); PG8_BAR; PG8_SCHED;
            PG8_LDA(At, 1, 1); PG8_STAGE(PG8_SB(1, 0), b3, voffB); PG8_STAGE(PG8_SB(1, 1), b3 + hstep, voffB); PG8_STAGE(PG8_SA(1, 0), a3, voffA);
            PG8_WAIT_V(8); PG8_WAIT_L(0); PG8_BAR; PG8_MMA(1, 0, At, B0); PG8_MMA(1, 1, At, B1); PG8_BAR; PG8_SCHED;
        }
        if (wr == 0) PG8_BAR;
        E(acc, cur, wr, wc, fr, fq);
        if (!has_next) break;
        if (!(Epi::KEEP && E.keep(cur))) {
#pragma unroll
            for (int a = 0; a < 2; ++a)
#pragma unroll
                for (int b = 0; b < 2; ++b)
#pragma unroll
                    for (int m = 0; m < 4; ++m)
#pragma unroll
                        for (int n = 0; n < 2; ++n) acc[a][b][m][n] = (f32x4){0.f, 0.f, 0.f, 0.f};
        }
        cur = nxt; cA = nA; cB = nB; ++ui;
        if (wr == 1) PG8_BAR;
    }
    PG8_WAIT_V(0);
    PG8_BAR;
#undef PG8_SA
#undef PG8_SB
#undef PG8_STAGE
#undef PG8_LDA
#undef PG8_LDB
#undef PG8_MMA
#undef PG8_WAIT_V
#undef PG8_WAIT_L
#undef PG8_BAR
#undef PG8_SCHED
}

struct EpiSwiglu {
    static constexpr bool PERM = true, KEEP = false;
    bf16_t* O;
    __device__ __forceinline__ bool keep(const Unit&) const { return false; }
    __device__ __forceinline__ void operator()(f32x4 (&acc)[2][2][4][2], const Unit& u, int wr, int wc, int fr, int fq) const {
        const int row0 = u.pm * BM + wr * 64 + fr, col0 = u.pn * 128 + wc * 32 + 8 * fq;
#pragma unroll
        for (int ai = 0; ai < 2; ++ai)
#pragma unroll
            for (int m = 0; m < 4; ++m) {
                bf16_t* rowp = O + (size_t)(row0 + ai * HALF + m * 16) * FF + col0;
                float v[8];
#pragma unroll
                for (int n = 0; n < 2; ++n)
#pragma unroll
                    for (int i = 0; i < 4; ++i) { const float gt = acc[ai][0][m][n][i], up = acc[ai][1][m][n][i]; v[n * 4 + i] = gt * sigmoidf_(gt) * up; }
                u32x4 w; w.x = pk2(v[0], v[1]); w.y = pk2(v[2], v[3]); w.z = pk2(v[4], v[5]); w.w = pk2(v[6], v[7]);
                *(u32x4*)rowp = w;
            }
    }
};
struct EpiResid {
    static constexpr bool PERM = false, KEEP = false;
    bf16_t* U; const float* xp; const float* xs; const bf16_t* hb; float scale; int mode;
    __device__ __forceinline__ bool keep(const Unit&) const { return false; }
    __device__ __forceinline__ void operator()(f32x4 (&acc)[2][2][4][2], const Unit& u, int wr, int wc, int fr, int fq) const {
        const int row0 = u.pm * BM + wr * 64 + fr, col0 = u.pn * BM + wc * 32 + 4 * fq;
#pragma unroll
        for (int ai = 0; ai < 2; ++ai)
#pragma unroll
            for (int m = 0; m < 4; ++m) {
                const int r = row0 + ai * HALF + m * 16;
                bf16_t* op = U + (size_t)r * DM;
                if (mode == 0) {
                    const float* bp = (r < TP ? xp + (size_t)r * DM : xs + (size_t)(r - TP) * DM);
#pragma unroll
                    for (int bj = 0; bj < 2; ++bj)
#pragma unroll
                        for (int n = 0; n < 2; ++n) { const int c = col0 + bj * HALF + n * 16; const f32x4 b = *(const f32x4*)(bp + c); const f32x4 o = b * ALPHA + acc[ai][bj][m][n] * scale; *(u32x2*)(op + c) = (u32x2){pk2(o[0], o[1]), pk2(o[2], o[3])}; }
                } else {
                    const bf16_t* bp = hb + (size_t)r * DM;
#pragma unroll
                    for (int bj = 0; bj < 2; ++bj)
#pragma unroll
                        for (int n = 0; n < 2; ++n) { const int c = col0 + bj * HALF + n * 16; const u32x2 w = *(const u32x2*)(bp + c);
                            const f32x4 b = (f32x4){bflo(w.x), bfhi(w.x), bflo(w.y), bfhi(w.y)}; const f32x4 o = b * ALPHA + acc[ai][bj][m][n] * scale; *(u32x2*)(op + c) = (u32x2){pk2(o[0], o[1]), pk2(o[2], o[3])}; }
                }
            }
    }
};
struct EpiSplitBf16 {
    static constexpr bool PERM = true, KEEP = false;
    bf16_t* dst[7]; float* pk; float* sk; float* pv; float* sv; int kt, vt;
    __device__ __forceinline__ bool keep(const Unit&) const { return false; }
    __device__ __forceinline__ void operator()(f32x4 (&acc)[2][2][4][2], const Unit& u, int wr, int wc, int fr, int fq) const {
        const int t = u.pn >> 2; bf16_t* base = (t == 0 ? dst[0] : t == 1 ? dst[1] : t == 2 ? dst[2] : t == 3 ? dst[3] : t == 4 ? dst[4] : t == 5 ? dst[5] : dst[6]);
        const int row0 = u.pm * BM + wr * 64 + fr, col0 = (u.pn & 3) * BM + wc * 32 + 8 * fq;
        float* fbase = nullptr;
        if (t == kt || t == vt) {
            if (u.pm >= 256) fbase = (t == kt ? sk : sv) + (size_t)(u.pm * BM - TP) * DM;
            else if ((u.pm & 7) >= 6) fbase = (t == kt ? pk : pv) + ((size_t)(u.pm >> 3) * 512 + (size_t)((u.pm & 7) - 6) * 256) * DM;
        }
#pragma unroll
        for (int ai = 0; ai < 2; ++ai)
#pragma unroll
            for (int m = 0; m < 4; ++m) {
                const int r = row0 + ai * HALF + m * 16;
                bf16_t* rowp = base + (size_t)r * DM + col0;
#pragma unroll
                for (int bj = 0; bj < 2; ++bj) {
                    const f32x4 v0 = acc[ai][bj][m][0], v1 = acc[ai][bj][m][1];
                    u32x4 w; w.x = pk2(v0[0], v0[1]); w.y = pk2(v0[2], v0[3]); w.z = pk2(v1[0], v1[1]); w.w = pk2(v1[2], v1[3]);
                    *(u32x4*)(rowp + bj * HALF) = w;
                    if (fbase) { float* fp = fbase + (size_t)(r - u.pm * BM) * DM + col0 + bj * HALF; *(f32x4*)fp = v0; *(f32x4*)(fp + 4) = v1; }
                }
            }
    }
};
struct EpiMerge {
    static constexpr bool PERM = true, KEEP = false;
    bf16_t* MG; u32x4* scr;
    __device__ __forceinline__ bool keep(const Unit&) const { return false; }
    __device__ __forceinline__ void operator()(const f32x4 (&acc)[2][2][4][2], const Unit& u, int wr, int wc, int fr, int fq) const {
        const int tid = threadIdx.x;
        const int row0 = u.pm * BM + wr * 64 + fr, col0 = u.pn * BM + wc * 32 + 8 * fq;
#define PINP(x) asm volatile("" : "+v"(x))
        if (u.seg == 0 || u.seg == 2) {
            int qa = tid; PINP(qa);
#pragma unroll
            for (int k = 0; k < 16; ++k) {
                const f32x4 v0 = acc[k >> 3][k & 1][(k >> 1) & 3][0], v1 = acc[k >> 3][k & 1][(k >> 1) & 3][1];
                u32x4 w; w.x = pk2(sigmoidf_(v0[0]), sigmoidf_(v0[1])); w.y = pk2(sigmoidf_(v0[2]), sigmoidf_(v0[3]));
                w.z = pk2(sigmoidf_(v1[0]), sigmoidf_(v1[1])); w.w = pk2(sigmoidf_(v1[2]), sigmoidf_(v1[3]));
                scr[qa] = w; qa += 512; PINP(qa);
            }
        } else if (u.seg == 1) {
            int qa = tid, qc = tid + 16 * 512; PINP(qa); PINP(qc);
#pragma unroll
            for (int k = 0; k < 16; ++k) {
                const f32x4 v0 = acc[k >> 3][k & 1][(k >> 1) & 3][0], v1 = acc[k >> 3][k & 1][(k >> 1) & 3][1];
                const u32x4 a = scr[qa];
                const f32x4 c0 = (f32x4){v0[0] * bflo(a.x), v0[1] * bfhi(a.x), v0[2] * bflo(a.y), v0[3] * bfhi(a.y)};
                const f32x4 c1 = (f32x4){v1[0] * bflo(a.z), v1[1] * bfhi(a.z), v1[2] * bflo(a.w), v1[3] * bfhi(a.w)};
                *(f32x4*)(scr + qc) = c0; *(f32x4*)(scr + qc + 512) = c1;
                qa += 512; qc += 1024; PINP(qa); PINP(qc);
            }
        } else {
            int qa = tid, qc = tid + 16 * 512; PINP(qa); PINP(qc);
            int mo = row0 * DM + col0; PINP(mo);
#pragma unroll
            for (int k = 0; k < 16; ++k) {
                const int ai = k >> 3, bj = k & 1, m = (k >> 1) & 3;
                const f32x4 v0 = acc[ai][bj][m][0], v1 = acc[ai][bj][m][1];
                const u32x4 b = scr[qa];
                const f32x4 c0 = *(const f32x4*)(scr + qc), c1 = *(const f32x4*)(scr + qc + 512);
                u32x4 w; w.x = pk2(c0[0] + v0[0] * bflo(b.x), c0[1] + v0[1] * bfhi(b.x)); w.y = pk2(c0[2] + v0[2] * bflo(b.y), c0[3] + v0[3] * bfhi(b.y));
                w.z = pk2(c1[0] + v1[0] * bflo(b.z), c1[1] + v1[1] * bfhi(b.z)); w.w = pk2(c1[2] + v1[2] * bflo(b.w), c1[3] + v1[3] * bfhi(b.w));
                *(u32x4*)(MG + mo + (ai * HALF + m * 16) * DM + bj * HALF) = w;
                qa += 512; qc += 1024; PINP(qa); PINP(qc);
            }
        }
#undef PINP
    }
};
}

struct Args {
    const float* in[28];
    float* out; unsigned char* ws;
    int ph_lo, ph_hi;
};
enum { I_XP = 0, I_XS, I_SCONV, I_SC, I_SN, I_SM, I_CK, I_CV, I_WIN, I_BI, I_BF, I_CONVW, I_CONVB, I_MLNG, I_RELB, I_WMLP, I_WATTP, I_WOUT,
       I_GU1, I_D1, I_GU2, I_D2, I_LN1G, I_LN1B, I_LN2G, I_LN2B, I_LN3G, I_LN3B };

__device__ __forceinline__ void transpose_item(const float* W, int ldw, int col0, int K, int N, bf16_t* WT, int mode, LAS float* scr, int item, int lane) {
    const int nblk = N / 32, kb = item / nblk, nb = item % nblk, k0 = 64 * kb, n0 = 32 * nb;
    {
        const int n4 = (lane & 7) * 4, kq = lane >> 3;
        f32x4 wv[8];
#pragma unroll
        for (int i = 0; i < 8; ++i) wv[i] = *(const f32x4*)(W + (size_t)(k0 + kq + 8 * i) * ldw + col0 + n0 + n4);
#pragma unroll
        for (int i = 0; i < 8; ++i) { LAS float* d = scr + (kq + 8 * i) * 33 + n4; d[0] = wv[i][0]; d[1] = wv[i][1]; d[2] = wv[i][2]; d[3] = wv[i][3]; }
    }
    asm volatile("s_waitcnt lgkmcnt(0)" ::: "memory");
    const int c = lane & 7;
#pragma unroll
    for (int j = 0; j < 4; ++j) { const int nn = (lane >> 3) + 8 * j; const LAS float* s = scr + (8 * c) * 33 + nn;
        u32x4 o; o.x = pk2(s[0 * 33], s[1 * 33]); o.y = pk2(s[2 * 33], s[3 * 33]); o.z = pk2(s[4 * 33], s[5 * 33]); o.w = pk2(s[6 * 33], s[7 * 33]);
        const int n = n0 + nn;
        const int drow = (mode == 1) ? (256 * ((n % FF) / 128) + 128 * (n / FF) + (n % 128)) : n;
        *(u32x4*)(WT + (size_t)drow * K + k0 + 8 * c) = o; }
    asm volatile("s_waitcnt lgkmcnt(0)" ::: "memory");
}
__device__ __forceinline__ void cvt_f32_bf16(const float* src, bf16_t* dst, size_t n8, size_t i0, size_t stride) {
    for (size_t i = i0; i < n8; i += stride) {
        const f32x4 a = *(const f32x4*)(src + i * 8), b = *(const f32x4*)(src + i * 8 + 4);
        u32x4 w; w.x = pk2(a[0], a[1]); w.y = pk2(a[2], a[3]); w.z = pk2(b[0], b[1]); w.w = pk2(b[2], b[3]);
        *(u32x4*)(dst + i * 8) = w;
    }
}
__device__ __forceinline__ void p0_prologue(const Args& a, LAS unsigned char* lds) {
    const int tid = threadIdx.x, lane = tid & 63, wave = tid >> 6;
    LAS float* scr = (LAS float*)(lds + wave * 16384);
    const int gw = blockIdx.x * 8 + wave, NGW = gridDim.x * 8;
    unsigned char* ws = a.ws;
    constexpr int I_GU = (DM / 64) * (2 * FF / 32), I_DN = (FF / 64) * (DM / 32), I_ML = (DM / 64) * (4096 / 32), I_AT = (DM / 64) * (3072 / 32), I_SQ = (DM / 64) * (DM / 32);
    constexpr int NITEMS = 2 * I_GU + 2 * I_DN + I_ML + I_AT + 5 * I_SQ;
    for (int it = gw; it < NITEMS; it += NGW) {
        int r = it;
        if (r < I_GU) { transpose_item(a.in[I_GU1], 2 * FF, 0, DM, 2 * FF, (bf16_t*)(ws + WS_WGU1), 1, scr, r, lane); continue; } r -= I_GU;
        if (r < I_GU) { transpose_item(a.in[I_GU2], 2 * FF, 0, DM, 2 * FF, (bf16_t*)(ws + WS_WGU2), 1, scr, r, lane); continue; } r -= I_GU;
        if (r < I_DN) { transpose_item(a.in[I_D1], DM, 0, FF, DM, (bf16_t*)(ws + WS_WD1), 0, scr, r, lane); continue; } r -= I_DN;
        if (r < I_DN) { transpose_item(a.in[I_D2], DM, 0, FF, DM, (bf16_t*)(ws + WS_WD2), 0, scr, r, lane); continue; } r -= I_DN;
        if (r < I_ML) { transpose_item(a.in[I_WIN], INW, 0, DM, 4096, (bf16_t*)(ws + WS_WML), 0, scr, r, lane); continue; } r -= I_ML;
        if (r < I_AT) { transpose_item(a.in[I_WIN], INW, 4104, DM, 3072, (bf16_t*)(ws + WS_WATT), 0, scr, r, lane); continue; } r -= I_AT;
        if (r < I_SQ) { transpose_item(a.in[I_WIN], INW, 7176, DM, DM, (bf16_t*)(ws + WS_WGM), 0, scr, r, lane); continue; } r -= I_SQ;
        if (r < I_SQ) { transpose_item(a.in[I_WIN], INW, 8200, DM, DM, (bf16_t*)(ws + WS_WGA), 0, scr, r, lane); continue; } r -= I_SQ;
        if (r < I_SQ) { transpose_item(a.in[I_WMLP], DM, 0, DM, DM, (bf16_t*)(ws + WS_WMLP), 0, scr, r, lane); continue; } r -= I_SQ;
        if (r < I_SQ) { transpose_item(a.in[I_WATTP], DM, 0, DM, DM, (bf16_t*)(ws + WS_WATTP), 0, scr, r, lane); continue; } r -= I_SQ;
        transpose_item(a.in[I_WOUT], DM, 0, DM, DM, (bf16_t*)(ws + WS_WOUT), 0, scr, r, lane);
    }
    const size_t gt = (size_t)blockIdx.x * 512 + tid, NT = (size_t)gridDim.x * 512;
    for (size_t i = gt; i < 8 * 1024; i += NT) { const int c = (int)(i >> 10), k = (int)(i & 1023); ((float*)(ws + WS_WIF))[i] = a.in[I_WIN][(size_t)k * INW + 4096 + c]; }
    cvt_f32_bf16(a.in[I_XP], (bf16_t*)(ws + WS_HB), (size_t)TP * DM / 8, gt, NT);
    cvt_f32_bf16(a.in[I_XS], (bf16_t*)(ws + WS_HB) + (size_t)TP * DM, (size_t)TS * DM / 8, gt, NT);
}

template <int MODE>
__device__ __forceinline__ void ln_pass(const bf16_t* Ub, float* Yout, bf16_t* HB, const float* g, const float* bta, const float* WIF, float* IFo, int row_lo, int row_hi, int cu_lo, int ncu) {
    int tid = threadIdx.x; asm volatile("" : "+v"(tid)); const int lane = tid & 63, wave = tid >> 6;
    const int gw = ((int)blockIdx.x - cu_lo) * 8 + wave, NGW = ncu * 8;
    if (gw < 0 || gw >= NGW) return;
    constexpr int R = 2;
    f32x4 gg[4], bb[4];
#pragma unroll
    for (int j = 0; j < 4; ++j) { gg[j] = *(const f32x4*)(g + 4 * lane + 256 * j); bb[j] = *(const f32x4*)(bta + 4 * lane + 256 * j); }
    f32x4 wif[MODE == 1 ? 8 : 1][4];
    if (MODE == 1) {
#pragma unroll
        for (int c = 0; c < 8; ++c)
#pragma unroll
            for (int j = 0; j < 4; ++j) wif[c][j] = *(const f32x4*)(WIF + c * 1024 + 4 * lane + 256 * j);
    }
    for (int row0 = row_lo + gw * R; row0 < row_hi; row0 += NGW * R) {
        f32x4 v[R][4]; float s[R], s2[R];
#pragma unroll
        for (int r = 0; r < R; ++r) {
            const bf16_t* ur = Ub + (size_t)(row0 + r) * DM + 4 * lane;
#pragma unroll
            for (int j = 0; j < 4; ++j) { const u32x2 w = *(const u32x2*)(ur + 256 * j); v[r][j] = (f32x4){bflo(w.x), bfhi(w.x), bflo(w.y), bfhi(w.y)}; }
        }
#pragma unroll
        for (int r = 0; r < R; ++r) { s[r] = 0.f;
#pragma unroll
            for (int j = 0; j < 4; ++j) s[r] += (v[r][j][0] + v[r][j][1]) + (v[r][j][2] + v[r][j][3]); }
#pragma unroll
        for (int o = 1; o < 64; o <<= 1) {
#pragma unroll
            for (int r = 0; r < R; ++r) s[r] += __shfl_xor(s[r], o); }
#pragma unroll
        for (int r = 0; r < R; ++r) { const float mean = s[r] * (1.f / DM); s2[r] = 0.f;
#pragma unroll
            for (int j = 0; j < 4; ++j) { v[r][j] = v[r][j] - mean; s2[r] += (v[r][j][0] * v[r][j][0] + v[r][j][1] * v[r][j][1]) + (v[r][j][2] * v[r][j][2] + v[r][j][3] * v[r][j][3]); } }
#pragma unroll
        for (int o = 1; o < 64; o <<= 1) {
#pragma unroll
            for (int r = 0; r < R; ++r) s2[r] += __shfl_xor(s2[r], o); }
#pragma unroll
        for (int r = 0; r < R; ++r) {
            const float rstd = 1.f / sqrtf(s2[r] * (1.f / DM) + LN_EPS);
#pragma unroll
            for (int j = 0; j < 4; ++j) v[r][j] = v[r][j] * rstd * gg[j] + bb[j];
            if (MODE == 3) {
                float* ur = Yout + (size_t)(row0 + r) * DM + 4 * lane;
#pragma unroll
                for (int j = 0; j < 4; ++j) *(f32x4*)(ur + 256 * j) = v[r][j];
            } else {
                bf16_t* hr = HB + (size_t)(row0 + r) * DM + 4 * lane;
#pragma unroll
                for (int j = 0; j < 4; ++j) { u32x2 w; w.x = pk2(v[r][j][0], v[r][j][1]); w.y = pk2(v[r][j][2], v[r][j][3]); *(u32x2*)(hr + 256 * j) = w; }
            }
        }
        if (MODE == 1) {
#pragma unroll
            for (int r = 0; r < R; ++r) {
                float d[8];
#pragma unroll
                for (int c = 0; c < 8; ++c) { d[c] = 0.f;
#pragma unroll
                    for (int j = 0; j < 4; ++j) { const f32x4 w = wif[MODE == 1 ? c : 0][j]; d[c] += (v[r][j][0] * w[0] + v[r][j][1] * w[1]) + (v[r][j][2] * w[2] + v[r][j][3] * w[3]); } }
                const bool b0 = lane & 1, b1 = lane & 2, b2 = lane & 4;
                float e[4], f[2], hsum;
#pragma unroll
                for (int i = 0; i < 4; ++i) { const float t_ = __shfl_xor(b0 ? d[i] : d[i + 4], 1); e[i] = (b0 ? d[i + 4] : d[i]) + t_; }
#pragma unroll
                for (int i = 0; i < 2; ++i) { const float t_ = __shfl_xor(b1 ? e[i] : e[i + 2], 2); f[i] = (b1 ? e[i + 2] : e[i]) + t_; }
                { const float t_ = __shfl_xor(b2 ? f[0] : f[1], 4); hsum = (b2 ? f[1] : f[0]) + t_; }
                hsum += __shfl_xor(hsum, 8); hsum += __shfl_xor(hsum, 16); hsum += __shfl_xor(hsum, 32);
                const int col = (b0 ? 4 : 0) + (b1 ? 2 : 0) + (b2 ? 1 : 0);
                if (lane < 8) IFo[(size_t)(row0 + r) * 8 + col] = hsum;
            }
        }
    }
}

__device__ __forceinline__ void headln_pass(bf16_t* H, const bf16_t* MLO, const float* ng) {
    int tid = threadIdx.x; asm volatile("" : "+v"(tid)); const int lane = tid & 63, wave = tid >> 6;
    const int gw = blockIdx.x * 8 + wave, NGW = gridDim.x * 8;
    const int c0 = (lane >> 4) * 256 + (lane & 15) * 16;
    float gv[16];
#pragma unroll
    for (int i = 0; i < 16; ++i) gv[i] = ng[c0 + i];
    for (int rowb = gw; rowb < TT; rowb += 2 * NGW) {
        u32x4 a0[2], a1[2], o0[2], o1[2];
#pragma unroll
        for (int q = 0; q < 2; ++q) {
            const int row = (rowb + q * NGW < TT) ? rowb + q * NGW : rowb;
            a0[q] = *(const u32x4*)(H + (size_t)row * DM + c0); a1[q] = *(const u32x4*)(H + (size_t)row * DM + c0 + 8);
            o0[q] = *(const u32x4*)(MLO + (size_t)row * DM + c0); o1[q] = *(const u32x4*)(MLO + (size_t)row * DM + c0 + 8);
        }
#pragma unroll
        for (int q = 0; q < 2; ++q) {
            const int row = rowb + q * NGW;
            float v[16], og[16];
            const unsigned aw[8] = {a0[q].x, a0[q].y, a0[q].z, a0[q].w, a1[q].x, a1[q].y, a1[q].z, a1[q].w}, ow[8] = {o0[q].x, o0[q].y, o0[q].z, o0[q].w, o1[q].x, o1[q].y, o1[q].z, o1[q].w};
#pragma unroll
            for (int i = 0; i < 8; ++i) { v[2 * i] = bflo(aw[i]); v[2 * i + 1] = bfhi(aw[i]); og[2 * i] = bflo(ow[i]); og[2 * i + 1] = bfhi(ow[i]); }
            float sm = 0.f;
#pragma unroll
            for (int i = 0; i < 16; ++i) sm += v[i];
#pragma unroll
            for (int o = 1; o < 16; o <<= 1) sm += __shfl_xor(sm, o);
            const float mean = sm * (1.f / 256.f); float s2 = 0.f;
#pragma unroll
            for (int i = 0; i < 16; ++i) { v[i] -= mean; s2 += v[i] * v[i]; }
#pragma unroll
            for (int o = 1; o < 16; o <<= 1) s2 += __shfl_xor(s2, o);
            const float rstd = 1.f / sqrtf(s2 * (1.f / 256.f) + LN_EPS);
            unsigned w[8];
#pragma unroll
            for (int i = 0; i < 8; ++i) w[i] = pk2(v[2 * i] * rstd * gv[2 * i] * sigmoidf_(og[2 * i]), v[2 * i + 1] * rstd * gv[2 * i + 1] * sigmoidf_(og[2 * i + 1]));
            if (row < TT) {
                *(u32x4*)(H + (size_t)row * DM + c0) = (u32x4){w[0], w[1], w[2], w[3]};
                *(u32x4*)(H + (size_t)row * DM + c0 + 8) = (u32x4){w[4], w[5], w[6], w[7]};
            }
        }
    }
}

namespace ml {
constexpr int QS = 0, KS = 35840, VS = 71680, VW = 91136, PS = 110592, CW = 119808, NV = 130048, SC = 131072;
constexpr int QROW = 560, VROW = 304, PROW = 144;
constexpr int S_A = 0, S_PM = 256, S_WI = 512, S_EMT = 768, S_WS = 1024, S_RS0 = 1280, S_RS1 = 1536, S_QN = 1792, S_DEC = 2048, S_PAR = 2304;
static_assert(KS - QS >= 64 * QROW && VS - KS >= 64 * QROW && VW - VS >= 64 * VROW && PS - VW >= 64 * VROW && CW - PS >= 64 * PROW && NV - CW >= 10240 && SC - NV >= 1024 && SC + 2 * S_PAR <= LDS_BYTES - 64, "mlstm lds");

__device__ __forceinline__ void mlstm_item(const Args& a, LAS unsigned char* lds, int item) {
    const int tid = threadIdx.x, lane = tid & 63, wid = __builtin_amdgcn_readfirstlane(tid >> 6), fr = lane & 15, g = lane >> 4;
    const bool sample = item >= 256; const int it = sample ? item - 256 : item;
    const int b = it >> 3, h = (it >> 1) & 3, half = it & 1;
    const int row0 = sample ? TP + b * DSEQ : b * SEQ, nch = sample ? 1 : SEQ / 64;
    unsigned char* ws = a.ws;
    const bf16_t* MLQ = (const bf16_t*)(ws + WS_B0); const bf16_t* MLK = (const bf16_t*)(ws + WS_B0 + SZ1); const bf16_t* MLV = (const bf16_t*)(ws + WS_B0 + 2 * SZ1);
    const float* IFb = (const float*)(ws + WS_IF);
    float* out = a.out;
    const int e0 = 16 * wid;
    const int ecol = h * 256 + half * 128;
    LAS float* cw = (LAS float*)(lds + CW);
    for (int i = tid; i < 2 * 5 * 256; i += 512) { const int mat = i / 1280, r = (i % 1280) / 256, ch = i & 255; const int gc = mat * 1024 + h * 256 + ch;
        cw[i] = (r < 4) ? a.in[I_CONVW][r * 2048 + gc] : a.in[I_CONVB][gc]; }
    LAS float* nv = (LAS float*)(lds + NV);
    if (tid < 256) nv[tid] = sample ? a.in[I_SN][(b * 4 + h) * 256 + tid] : 0.f;
    f32x4 accC[16];
#pragma unroll
    for (int dt = 0; dt < 16; ++dt) accC[dt] = (f32x4){0.f, 0.f, 0.f, 0.f};
    if (sample) {
#pragma unroll
        for (int dt = 0; dt < 16; ++dt) { const float* cp = a.in[I_SC] + ((size_t)(b * 4 + h) * 256 + 16 * dt + 4 * g) * 256 + half * 128 + e0 + fr;
            accC[dt] = (f32x4){cp[0], cp[256], cp[512], cp[768]}; }
    }
    for (int i = tid; i < 2 * 3 * 256; i += 512) { const int mat = i / 768, r = (i % 768) / 256, ch = i & 255;
        const float v = sample ? a.in[I_SCONV][((size_t)b * 3 + r) * 2048 + mat * 1024 + h * 256 + ch] : 0.f;
        *(LAS bf16_t*)(lds + PS + i * 2) = (bf16_t)(pk2(v, 0.f) & 0xffffu); }
    float mstate = sample ? a.in[I_SM][b * 4 + h] : 0.f;
    const float bi = __int_as_float(__builtin_amdgcn_readfirstlane(__float_as_int(a.in[I_BI][h]))), bfg = __int_as_float(__builtin_amdgcn_readfirstlane(__float_as_int(a.in[I_BF][h])));
    __syncthreads();
    const int cmat = tid >> 8, chp2 = (tid & 127) * 2, rh = (tid >> 7) & 1;
    const int eg8 = (tid & 15) * 8, vr0 = 4 * ((tid >> 4) & 15);
    unsigned raw[35];
    {
        const bf16_t* src = (cmat ? MLK : MLQ) + h * 256 + chp2;
#pragma unroll
        for (int r = 0; r < 35; ++r) { int t = 32 * rh - 3 + r; if (t < 0) t = 0; raw[r] = *(const unsigned*)(src + ((size_t)row0 + t) * DM); }
        if (rh == 0) {
#pragma unroll
            for (int r = 0; r < 3; ++r) raw[r] = *(const LAS unsigned*)(lds + PS + (cmat * 768 + r * 256 + chp2) * 2);
        }
    }
    float pxi = 0.f, pxf = 0.f;
    if (wid == 0) { pxi = IFb[((size_t)row0 + lane) * 8 + h]; pxf = IFb[((size_t)row0 + lane) * 8 + 4 + h]; }
    for (int c = 0; c < nch; ++c) {
        const int par = c & 1;
        LAS float* sc = (LAS float*)(lds + SC + par * S_PAR);
        const size_t rbase = (size_t)row0 + (size_t)c * 64;
        if (wid == 0) {
            const float xi = pxi + bi;
            const float xf = pxf + bfg;
            if (c + 1 < nch) { pxi = IFb[(rbase + 64 + lane) * 8 + h]; pxf = IFb[(rbase + 64 + lane) * 8 + 4 + h]; }
            const float lf = fminf(xf, 0.f) - __logf(1.0f + __expf(-fabsf(xf)));
            float bc = lf;
#pragma unroll
            for (int o = 1; o < 64; o <<= 1) { const float t_ = __shfl_up(bc, o); if (lane >= o) bc += t_; }
            const float av = xi - bc;
            float pmx = av;
#pragma unroll
            for (int o = 1; o < 64; o <<= 1) { const float t_ = __shfl_up(pmx, o); if (lane >= o) pmx = fmaxf(pmx, t_); }
            pmx = fmaxf(pmx, mstate);
            const float pm63 = __shfl(pmx, 63), b63 = __shfl(bc, 63);
            sc[S_A / 4 + lane] = av; sc[S_PM / 4 + lane] = pmx; sc[S_WI / 4 + lane] = __expf(mstate - pmx); sc[S_EMT / 4 + lane] = __expf(-(bc + pmx));
            sc[S_WS / 4 + lane] = __expf(av - pm63);
            if (lane == 0) sc[S_DEC / 4] = __expf(mstate - pm63);
            mstate = __int_as_float(__builtin_amdgcn_readfirstlane(__float_as_int(b63 + pm63)));
        }
        const bool conv_out = (c == nch - 1 && half == 0 && rh == 1);
        __syncthreads();
#ifndef NO_CONV
        u32x4 rv[4];
        {
            if (conv_out) {
                float* co = out + (sample ? O_SCONV : O_PCONV) + (size_t)b * 3 * 2048 + cmat * 1024 + h * 256 + chp2;
#pragma unroll
                for (int j = 0; j < 3; ++j) { const unsigned x = raw[32 + j]; co[j * 2048] = bflo(x); co[j * 2048 + 1] = bfhi(x); }
            }
            const LAS float* w = cw + cmat * 1280 + chp2;
            float wl[5], wh[5];
#pragma unroll
            for (int j = 0; j < 5; ++j) { wl[j] = w[j * 256]; wh[j] = w[j * 256 + 1]; }
            const float scl = cmat ? 0.0625f : 1.0f;
            LAS unsigned char* dstS = lds + (cmat ? KS : QS) + (32 * rh) * QROW + chp2 * 2;
            float x0l = bflo(raw[0]), x0h = bfhi(raw[0]), x1l = bflo(raw[1]), x1h = bfhi(raw[1]), x2l = bflo(raw[2]), x2h = bfhi(raw[2]);
#pragma unroll
            for (int t = 0; t < 32; ++t) {
                const float x3l = bflo(raw[t + 3]), x3h = bfhi(raw[t + 3]);
                float ol = __builtin_fmaf(wl[0], x0l, wl[4]), oh = __builtin_fmaf(wh[0], x0h, wh[4]);
                ol = __builtin_fmaf(wl[1], x1l, ol); oh = __builtin_fmaf(wh[1], x1h, oh);
                ol = __builtin_fmaf(wl[2], x2l, ol); oh = __builtin_fmaf(wh[2], x2h, oh);
                ol = __builtin_fmaf(wl[3], x3l, ol); oh = __builtin_fmaf(wh[3], x3h, oh);
                ol = ol * sigmoidf_(ol) * scl; oh = oh * sigmoidf_(oh) * scl;
                *(LAS unsigned*)(dstS + t * QROW) = pk2(ol, oh);
                x0l = x1l; x0h = x1h; x1l = x2l; x1h = x2h; x2l = x3l; x2h = x3h;
            }
        }
        if (tid < 256) {
#pragma unroll
            for (int r = 0; r < 4; ++r) rv[r] = *(const u32x4*)(MLV + (rbase + vr0 + r) * DM + ecol + eg8);
#pragma unroll
            for (int r = 0; r < 4; ++r) {
                const float wsv = sc[S_WS / 4 + vr0 + r]; const u32x4 x = rv[r];
                *(LAS u32x4*)(lds + VS + (vr0 + r) * VROW + eg8 * 2) = x;
                *(LAS u32x4*)(lds + VW + (vr0 + r) * VROW + eg8 * 2) = (u32x4){pk2(bflo(x.x) * wsv, bfhi(x.x) * wsv), pk2(bflo(x.y) * wsv, bfhi(x.y) * wsv),
                                                                              pk2(bflo(x.z) * wsv, bfhi(x.z) * wsv), pk2(bflo(x.w) * wsv, bfhi(x.w) * wsv)};
            }
        }
#endif
        __syncthreads();
        if (c + 1 < nch) {
            const bf16_t* src = (cmat ? MLK : MLQ) + h * 256 + chp2 + (rbase + 64 + 32 * rh - 3) * DM;
#pragma unroll
            for (int r = 0; r < 35; ++r) raw[r] = *(const unsigned*)(src + (size_t)r * DM);
        }
#ifndef NO_S
        {
            const int tt = wid & 3, sh = wid >> 2;
            f32x4 sa[2] = {(f32x4){0.f, 0.f, 0.f, 0.f}, (f32x4){0.f, 0.f, 0.f, 0.f}};
            int qoff = QS + (16 * tt + fr) * QROW + 16 * g, koff = KS + (32 * sh + fr) * QROW + 16 * g;
            asm volatile("" : "+v"(qoff), "+v"(koff));
            bf16x8 sq[2][2], sk[2][2][2];
#define LD_S(bi, kp) do { _Pragma("unroll") for (int k2 = 0; k2 < 2; ++k2) { sq[bi][k2] = *(const LAS bf16x8*)(lds + qoff + 64 * (2 * (kp) + k2)); \
                _Pragma("unroll") for (int st2 = 0; st2 < 2; ++st2) sk[bi][k2][st2] = *(const LAS bf16x8*)(lds + koff + st2 * 16 * QROW + 64 * (2 * (kp) + k2)); } } while (0)
            LD_S(0, 0);
#pragma unroll
            for (int kp = 0; kp < 4; ++kp) {
                if (kp < 3) LD_S((kp + 1) & 1, kp + 1);
                __builtin_amdgcn_sched_barrier(0);
#pragma unroll
                for (int k2 = 0; k2 < 2; ++k2)
#pragma unroll
                    for (int st2 = 0; st2 < 2; ++st2) sa[st2] = __builtin_amdgcn_mfma_f32_16x16x32_bf16(sk[kp & 1][k2][st2], sq[kp & 1][k2], sa[st2], 0, 0, 0);
                __builtin_amdgcn_sched_barrier(0);
            }
#undef LD_S
            const int t = 16 * tt + fr; const float pmt = sc[S_PM / 4 + t]; float rs = 0.f;
#pragma unroll
            for (int st2 = 0; st2 < 2; ++st2) {
                const int s0 = 16 * (2 * sh + st2) + 4 * g;
                const f32x4 av = *(const LAS f32x4*)(sc + S_A / 4 + s0);
                float p[4];
#pragma unroll
                for (int jj = 0; jj < 4; ++jj) { p[jj] = (s0 + jj <= t) ? sa[st2][jj] * __expf(av[jj] - pmt) : 0.f; rs += p[jj]; }
                *(LAS u32x2*)(lds + PS + t * PROW + s0 * 2) = (u32x2){pk2(p[0], p[1]), pk2(p[2], p[3])};
            }
            rs += __shfl_xor(rs, 16); rs += __shfl_xor(rs, 32);
            if (g == 0) sc[(sh ? S_RS1 : S_RS0) / 4 + t] = rs;
            int tidS = tid; asm volatile("" : "+v"(tidS)); const int tq = tidS >> 3, part = tidS & 7; float d = 0.f;
#pragma unroll
            for (int i = 0; i < 4; ++i) {
                const u32x4 x = *(const LAS u32x4*)(lds + QS + tq * QROW + (32 * part + 8 * i) * 2);
                const f32x4 n0 = *(const LAS f32x4*)(nv + 32 * part + 8 * i), n1 = *(const LAS f32x4*)(nv + 32 * part + 8 * i + 4);
                d += bflo(x.x) * n0[0] + bfhi(x.x) * n0[1] + bflo(x.y) * n0[2] + bfhi(x.y) * n0[3] + bflo(x.z) * n1[0] + bfhi(x.z) * n1[1] + bflo(x.w) * n1[2] + bfhi(x.w) * n1[3];
            }
            d += __shfl_xor(d, 1); d += __shfl_xor(d, 2); d += __shfl_xor(d, 4);
            if (part == 0) sc[S_QN / 4 + tq] = d;
        }
#endif
        __syncthreads();
#ifndef NO_H
        {
            f32x4 ao[4] = {(f32x4){0.f, 0.f, 0.f, 0.f}, (f32x4){0.f, 0.f, 0.f, 0.f}, (f32x4){0.f, 0.f, 0.f, 0.f}, (f32x4){0.f, 0.f, 0.f, 0.f}};
            int qa = QS + fr * QROW + 8 * g;
            asm volatile("" : "+v"(qa));
            u32x2 xq[2][2][4][2];
#define LD_Q(bi, kp) do { _Pragma("unroll") for (int k2 = 0; k2 < 2; ++k2) _Pragma("unroll") for (int tt = 0; tt < 4; ++tt) { \
                xq[bi][k2][tt][0] = *(const LAS u32x2*)(lds + qa + tt * 16 * QROW + 64 * (2 * (kp) + k2)); xq[bi][k2][tt][1] = *(const LAS u32x2*)(lds + qa + tt * 16 * QROW + 64 * (2 * (kp) + k2) + 32); } } while (0)
            LD_Q(0, 0);
#pragma unroll
            for (int kp = 0; kp < 4; ++kp) {
                if (kp < 3) LD_Q((kp + 1) & 1, kp + 1);
                __builtin_amdgcn_sched_barrier(0);
#pragma unroll
                for (int k2 = 0; k2 < 2; ++k2) {
                    const int kk = 2 * kp + k2;
                    const f32x4 c0 = accC[2 * kk], c1 = accC[2 * kk + 1];
                    const u32x4 bw = (u32x4){pk2(c0[0], c0[1]), pk2(c0[2], c0[3]), pk2(c1[0], c1[1]), pk2(c1[2], c1[3])};
                    const bf16x8 bfr = __builtin_bit_cast(bf16x8, bw);
#pragma unroll
                    for (int tt = 0; tt < 4; ++tt) {
                        const u32x2 x0 = xq[kp & 1][k2][tt][0], x1 = xq[kp & 1][k2][tt][1];
                        const bf16x8 afr = __builtin_bit_cast(bf16x8, (u32x4){x0.x, x0.y, x1.x, x1.y});
                        ao[tt] = __builtin_amdgcn_mfma_f32_16x16x32_bf16(afr, bfr, ao[tt], 0, 0, 0);
                    }
                }
                __builtin_amdgcn_sched_barrier(0);
            }
#undef LD_Q
#pragma unroll
            for (int tt = 0; tt < 4; ++tt) { const f32x4 wi = *(const LAS f32x4*)(sc + S_WI / 4 + 16 * tt + 4 * g); ao[tt] = ao[tt] * wi; }
            const int q = (lane & 15) >> 2, p = lane & 3;
            int va = VS + (8 * g + q) * VROW + (e0 + 4 * p) * 2, pa = PS + fr * PROW + 16 * g;
            asm volatile("" : "+v"(va), "+v"(pa));
#pragma unroll
            for (int ks = 0; ks < 2; ++ks) {
                const s16x4 v0 = tr_read(lds + va + ks * 32 * VROW);
                const s16x4 v1 = tr_read(lds + va + ks * 32 * VROW + 4 * VROW);
                const bf16x8 bfr = (bf16x8){v0[0], v0[1], v0[2], v0[3], v1[0], v1[1], v1[2], v1[3]};
#pragma unroll
                for (int tt = 0; tt < 4; ++tt) {
                    const bf16x8 afr = *(const LAS bf16x8*)(lds + pa + tt * 16 * PROW + 64 * ks);
                    ao[tt] = __builtin_amdgcn_mfma_f32_16x16x32_bf16(afr, bfr, ao[tt], 0, 0, 0);
                }
            }
            int hoff = 4 * g * DM + ecol + e0 + fr;
            int sco = (par * S_PAR) + 16 * g;
            asm volatile("" : "+v"(hoff), "+v"(sco));
            bf16_t* hp = (bf16_t*)(ws + WS_B0 + 2 * SZ1) + rbase * DM + hoff;
#pragma unroll
            for (int tt = 0; tt < 4; ++tt) {
                const LAS unsigned char* sb = lds + SC + sco + 64 * tt;
                const f32x4 wi = *(const LAS f32x4*)(sb + S_WI), qn = *(const LAS f32x4*)(sb + S_QN), r0 = *(const LAS f32x4*)(sb + S_RS0),
                            r1 = *(const LAS f32x4*)(sb + S_RS1), em = *(const LAS f32x4*)(sb + S_EMT);
#pragma unroll
                for (int jj = 0; jj < 4; ++jj) {
                    const float den = wi[jj] * qn[jj] + r0[jj] + r1[jj];
                    const float hv = ao[tt][jj] * rcpf_(fmaxf(fabsf(den), em[jj]));
                    hp[(size_t)(16 * tt + jj) * DM] = (bf16_t)(pk2(hv, 0.f) & 0xffffu);
                }
                __builtin_amdgcn_sched_barrier(0);
            }
        }
#endif
#ifndef NO_CU
        {
            const float dec = sc[S_DEC / 4];
            const int q = (lane & 15) >> 2, p = lane & 3;
            int vwa = VW + (8 * g + q) * VROW + (e0 + 4 * p) * 2, ka = KS + (8 * g + q) * QROW + 8 * p;
            asm volatile("" : "+v"(vwa), "+v"(ka));
            bf16x8 bw[2];
#pragma unroll
            for (int ks = 0; ks < 2; ++ks) {
                const s16x4 v0 = tr_read(lds + vwa + ks * 32 * VROW);
                const s16x4 v1 = tr_read(lds + vwa + ks * 32 * VROW + 4 * VROW);
                bw[ks] = (bf16x8){v0[0], v0[1], v0[2], v0[3], v1[0], v1[1], v1[2], v1[3]};
            }
            s16x4 kr[2][2][2][2];
#define LD_K(bi, gp) do { _Pragma("unroll") for (int d4 = 0; d4 < 2; ++d4) _Pragma("unroll") for (int ks = 0; ks < 2; ++ks) { \
                kr[bi][d4][ks][0] = tr_read(lds + ka + ks * 32 * QROW + (2 * (gp) + d4) * 32); kr[bi][d4][ks][1] = tr_read(lds + ka + ks * 32 * QROW + (2 * (gp) + d4) * 32 + 4 * QROW); } } while (0)
            LD_K(0, 0);
#pragma unroll
            for (int gp = 0; gp < 8; ++gp) {
                if (gp < 7) LD_K((gp + 1) & 1, gp + 1);
                __builtin_amdgcn_sched_barrier(0);
#pragma unroll
                for (int d4 = 0; d4 < 2; ++d4) {
                    const int dt = 2 * gp + d4;
                    accC[dt] = accC[dt] * dec;
#pragma unroll
                    for (int ks = 0; ks < 2; ++ks) {
                        const s16x4 k0 = kr[gp & 1][d4][ks][0], k1 = kr[gp & 1][d4][ks][1];
                        const bf16x8 afr = (bf16x8){k0[0], k0[1], k0[2], k0[3], k1[0], k1[1], k1[2], k1[3]};
                        accC[dt] = __builtin_amdgcn_mfma_f32_16x16x32_bf16(afr, bw[ks], accC[dt], 0, 0, 0);
                    }
                }
                __builtin_amdgcn_sched_barrier(0);
            }
#undef LD_K
            int tidN = tid; asm volatile("" : "+v"(tidN)); const int dn = tidN >> 1, sh2 = tidN & 1; float sn = 0.f;
#pragma unroll 8
            for (int s = 0; s < 32; ++s) { const int ss = 32 * sh2 + s; sn += sc[S_WS / 4 + ss] * bf1(*(const LAS bf16_t*)(lds + KS + ss * QROW + dn * 2)); }
            sn += __shfl_xor(sn, 1);
            if (sh2 == 0) nv[dn] = dec * nv[dn] + sn;
        }
#endif
    }
    __syncthreads();
    {
        float* Co = out + (sample ? O_SC : O_PC) + (size_t)(b * 4 + h) * 65536;
#pragma unroll
        for (int dt = 0; dt < 16; ++dt)
#pragma unroll
            for (int jj = 0; jj < 4; ++jj) Co[(size_t)(16 * dt + 4 * g + jj) * 256 + half * 128 + e0 + fr] = accC[dt][jj];
        if (half == 0) {
            if (tid < 256) out[(sample ? O_SN : O_PN) + (size_t)(b * 4 + h) * 256 + tid] = nv[tid];
            if (tid == 0) out[(sample ? O_SM : O_PM) + b * 4 + h] = mstate;
        }
    }
    __syncthreads();
}
}

namespace at {
constexpr int KB = 0, VB = 18432, TB = 55296, KROW = 144, VROWA = 288, VBUF = 64 * VROWA;
__device__ __forceinline__ void attn_unit(const Args& a, LAS unsigned char* lds, bool sample, int b, int h, int c0, int nch) {
    const int tid = threadIdx.x, lane = tid & 63, wid = __builtin_amdgcn_readfirstlane(tid >> 6), fr = lane & 15, g = lane >> 4;
    unsigned char* ws = a.ws;
    const bf16_t* AQ = (const bf16_t*)(ws + WS_B0 + 4 * SZ1); const bf16_t* AK = (const bf16_t*)(a.out + O_Y); const bf16_t* AV = AK + (size_t)TT * DM; bf16_t* AO = (bf16_t*)(ws + WS_B0 + 4 * SZ1);
    const bf16_t* CK = (const bf16_t*)(ws + WS_CK); const bf16_t* CV = (const bf16_t*)(ws + WS_CV);
    const int cw = c0 + (wid >> 1), qh = wid & 1; const bool active = (wid >> 1) < nch;
    const size_t qrow0 = sample ? (size_t)TP + b * DSEQ + 32 * qh : (size_t)b * SEQ + (size_t)cw * 64 + 32 * qh;
    LAS float* tbl = (LAS float*)(lds + TB);
    if (tid < 320) tbl[tid] = a.in[I_RELB][h * 257 + (tid < 256 ? tid : 256)] * 1.4426950408889634f;
    bf16x8 qf[2][2];
    if (active) {
#pragma unroll
        for (int tt = 0; tt < 2; ++tt)
#pragma unroll
            for (int ks = 0; ks < 2; ++ks) qf[tt][ks] = *(const bf16x8*)(AQ + (qrow0 + 16 * tt + fr) * DM + h * 64 + 32 * ks + 8 * g);
    }
    const int jlo = sample ? 0 : (c0 - 8 > 0 ? c0 - 8 : 0), jhi = sample ? 8 : c0 + nch - 1;
    const int lrow = tid >> 3, lch = (tid & 7) * 8;
    auto kv_src = [&](int j, const bf16_t*& kp, const bf16_t*& vp) {
        if (sample) { if (j < 8) { const size_t o = ((size_t)b * NPAST + j * 64 + lrow) * DM + h * 64 + lch; kp = CK + o; vp = CV + o; }
                      else { const size_t o = ((size_t)TP + b * DSEQ + lrow) * DM + h * 64 + lch; kp = AK + o; vp = AV + o; } }
        else { const size_t o = ((size_t)b * SEQ + (size_t)j * 64 + lrow) * DM + h * 64 + lch; kp = AK + o; vp = AV + o; }
    };
    u32x4 kreg, vreg;
    { const bf16_t *kp, *vp; kv_src(jlo, kp, vp); kreg = *(const u32x4*)kp; vreg = *(const u32x4*)vp; }
    *(LAS u32x4*)(lds + KB + lrow * KROW + lch * 2) = kreg; *(LAS u32x4*)(lds + VB + lrow * VROWA + lch * 2) = vreg;
    f32x4 o[4][2];
#pragma unroll
    for (int et = 0; et < 4; ++et) { o[et][0] = (f32x4){0.f, 0.f, 0.f, 0.f}; o[et][1] = (f32x4){0.f, 0.f, 0.f, 0.f}; }
    float mrun[2] = {-INFINITY, -INFINITY}, lsum[2] = {0.f, 0.f};
    __syncthreads();
    for (int j = jlo; j <= jhi; ++j) {
        const int buf = (j - jlo) & 1;
        if (j < jhi) { const bf16_t *kp, *vp; kv_src(j + 1, kp, vp); kreg = *(const u32x4*)kp; vreg = *(const u32x4*)vp; }
        const int dq = (sample ? 8 : cw) - j;
        if (active && dq >= 0 && dq <= 8) {
            const LAS unsigned char* kb = lds + KB + buf * 9216; const LAS unsigned char* vb = lds + VB + buf * VBUF;
            f32x4 s[4][2];
#pragma unroll
            for (int st = 0; st < 4; ++st) { s[st][0] = (f32x4){0.f, 0.f, 0.f, 0.f}; s[st][1] = (f32x4){0.f, 0.f, 0.f, 0.f}; }
#pragma unroll
            for (int ks = 0; ks < 2; ++ks)
#pragma unroll
                for (int st = 0; st < 4; ++st) {
                    const bf16x8 kf = *(const LAS bf16x8*)(kb + (16 * st + fr) * KROW + (32 * ks + 8 * g) * 2);
                    s[st][0] = __builtin_amdgcn_mfma_f32_16x16x32_bf16(kf, qf[0][ks], s[st][0], 0, 0, 0);
                    s[st][1] = __builtin_amdgcn_mfma_f32_16x16x32_bf16(kf, qf[1][ks], s[st][1], 0, 0, 0);
                }
            const float bfar = tbl[256];
            constexpr float SC2 = 0.125f * 1.4426950408889634f;
            if (dq < 3) {
                const int relb = 64 * dq + 32 * qh + fr - 4 * g + 128;
#pragma unroll
                for (int tt = 0; tt < 2; ++tt)
#pragma unroll
                    for (int st = 0; st < 4; ++st)
#pragma unroll
                        for (int jj = 0; jj < 4; ++jj) s[st][tt][jj] = __builtin_fmaf(s[st][tt][jj], SC2, tbl[relb + 16 * tt - 16 * st - jj]);
            } else {
#pragma unroll
                for (int tt = 0; tt < 2; ++tt)
#pragma unroll
                    for (int st = 0; st < 4; ++st) s[st][tt] = s[st][tt] * SC2 + bfar;
            }
#pragma unroll
            for (int tt = 0; tt < 2; ++tt) {
                float mx = fmaxf(fmaxf(s[0][tt][0], s[0][tt][1]), fmaxf(s[0][tt][2], s[0][tt][3]));
#pragma unroll
                for (int st = 1; st < 4; ++st) mx = fmaxf(fmaxf(mx, s[st][tt][0]), fmaxf(fmaxf(s[st][tt][1], s[st][tt][2]), s[st][tt][3]));
                mx = fmaxf(mx, __shfl_xor(mx, 16)); mx = fmaxf(mx, __shfl_xor(mx, 32));
                const float mnew = fmaxf(mrun[tt], mx), alpha = __builtin_amdgcn_exp2f(mrun[tt] - mnew);
                const bool chg = mnew > mrun[tt]; mrun[tt] = mnew;
                f32x4 psv = (f32x4){0.f, 0.f, 0.f, 0.f}; const float nmn = -mnew; const f32x4 nm4 = (f32x4){nmn, nmn, nmn, nmn};
#pragma unroll
                for (int st = 0; st < 4; ++st) {
                    const f32x4 d = s[st][tt] + nm4;
                    const f32x4 pv4 = (f32x4){__builtin_amdgcn_exp2f(d[0]), __builtin_amdgcn_exp2f(d[1]), __builtin_amdgcn_exp2f(d[2]), __builtin_amdgcn_exp2f(d[3])};
                    s[st][tt] = pv4; psv = psv + pv4;
                }
                lsum[tt] = lsum[tt] * alpha + ((psv[0] + psv[1]) + (psv[2] + psv[3]));
                if (__any(chg)) {
#pragma unroll
                    for (int et = 0; et < 4; ++et) o[et][tt] = o[et][tt] * alpha;
                }
            }
            const int q = (lane & 15) >> 2, p = lane & 3;
#pragma unroll
            for (int ks2 = 0; ks2 < 2; ++ks2) {
                bf16x8 pf[2];
#pragma unroll
                for (int tt = 0; tt < 2; ++tt) { const f32x4 p0 = s[2 * ks2][tt], p1 = s[2 * ks2 + 1][tt];
                    pf[tt] = __builtin_bit_cast(bf16x8, (u32x4){pk2(p0[0], p0[1]), pk2(p0[2], p0[3]), pk2(p1[0], p1[1]), pk2(p1[2], p1[3])}); }
#pragma unroll
                for (int et = 0; et < 4; ++et) {
                    const s16x4 v0 = tr_read(vb + (32 * ks2 + 4 * g + q) * VROWA + (16 * et + 4 * p) * 2);
                    const s16x4 v1 = tr_read(vb + (32 * ks2 + 16 + 4 * g + q) * VROWA + (16 * et + 4 * p) * 2);
                    const bf16x8 vf = (bf16x8){v0[0], v0[1], v0[2], v0[3], v1[0], v1[1], v1[2], v1[3]};
                    o[et][0] = __builtin_amdgcn_mfma_f32_16x16x32_bf16(vf, pf[0], o[et][0], 0, 0, 0);
                    o[et][1] = __builtin_amdgcn_mfma_f32_16x16x32_bf16(vf, pf[1], o[et][1], 0, 0, 0);
                }
            }
        }
        if (j < jhi) { *(LAS u32x4*)(lds + KB + (buf ^ 1) * 9216 + lrow * KROW + lch * 2) = kreg; *(LAS u32x4*)(lds + VB + (buf ^ 1) * VBUF + lrow * VROWA + lch * 2) = vreg; }
        __syncthreads();
    }
    if (active) {
#pragma unroll
        for (int tt = 0; tt < 2; ++tt) {
            float l = lsum[tt]; l += __shfl_xor(l, 16); l += __shfl_xor(l, 32);
            const float inv = 1.f / l;
#pragma unroll
            for (int et = 0; et < 4; ++et) {
                const f32x4 v = o[et][tt] * inv;
                *(u32x2*)(AO + (qrow0 + 16 * tt + fr) * DM + h * 64 + 16 * et + 4 * g) = (u32x2){pk2(v[0], v[1]), pk2(v[2], v[3])};
            }
        }
    }
}
}

constexpr int NPHASE = 14;
__global__ void __launch_bounds__(512, 2) mega_fwd(Args args) {
    extern __shared__ __attribute__((aligned(16))) unsigned char lds_raw[];
    LAS unsigned char* lds = (LAS unsigned char*)lds_raw;
    unsigned char* ws = args.ws;
    float* U = args.out + O_Y;
    bf16_t* HB = (bf16_t*)(ws + WS_HB);
    bf16_t* UB = (bf16_t*)(ws + WS_B0 + 3 * SZ1);
    bf16_t* ACT = (bf16_t*)(ws + WS_ACT);
    const int lo = args.ph_lo, hi = args.ph_hi;
    const int G = gridDim.x, blk = blockIdx.x;
#ifndef PH_MASK
#define PH_MASK 0xFFFF
#endif
#define IN(k) (((PH_MASK >> (k)) & 1) && lo <= (k) && (k) < hi)
#ifndef DUP_MASK
#define DUP_MASK 0
#endif
#define REP(k) for (int rep_ = 0; rep_ < 1 + ((DUP_MASK >> (k)) & 1); ++rep_)
    volatile LAS unsigned* bst = (volatile LAS unsigned*)(lds + LDS_BYTES - 64);
    if (threadIdx.x < 2) bst[threadIdx.x] = 0u;
    __syncthreads();
    if (hi - lo > 1) (void)xcd_barrier_post((unsigned*)(ws + WS_BAR), bst);
#define SEAM(k) do { if (IN(k) && IN((k) + 1)) { if ((k) == 0) cg::this_grid().sync(); else xcd_barrier((unsigned*)(args.ws + WS_BAR), (volatile LAS unsigned*)(lds + LDS_BYTES - 64)); } } while (0)

    if (IN(0)) { p0_prologue(args, lds); if (DUP_MASK & 1) { __syncthreads(); p0_prologue(args, lds); } }
    SEAM(0);
    if (IN(1)) {
        pg8::Gemm g{}; g.A[0] = HB; g.Bt[0] = (const bf16_t*)(ws + WS_WGU1); g.M = TT; g.N = 2 * FF; g.K = DM;
        pg8::StaticOrder S; S.init(TT, 2 * FF, G, blk, 1);
        pg8::EpiSwiglu E{ACT};
        pg8::gemm_phase(lds, g, S, E);
        if ((DUP_MASK >> 1) & 1) pg8::gemm_phase(lds, g, S, E);
    }
    SEAM(1);
    if (IN(2)) {
        pg8::Gemm g{}; g.A[0] = ACT; g.Bt[0] = (const bf16_t*)(ws + WS_WD1); g.M = TT; g.N = DM; g.K = FF;
        pg8::StaticOrder S; S.init(TP, DM, G, blk, 1);
        pg8::EpiResid E{UB, nullptr, nullptr, HB, 0.5f, 1};
        pg8::gemm_phase(lds, g, S, E);
    }
    SEAM(2);
    if (IN(3)) {
        if (blk < 16) {
            pg8::Gemm g{}; g.A[0] = ACT; g.Bt[0] = (const bf16_t*)(ws + WS_WD1); g.M = TT; g.N = DM; g.K = FF;
            pg8::StaticOrder S; S.init(TS, DM, G, blk, 1, TP / 256);
            pg8::EpiResid E{UB, nullptr, nullptr, HB, 0.5f, 1};
            pg8::gemm_phase(lds, g, S, E);
        } else {
            ln_pass<1>(UB, nullptr, HB, args.in[I_LN1G], args.in[I_LN1B], (const float*)(ws + WS_WIF), (float*)(ws + WS_IF), 0, TP, 16, G - 16);
            const size_t gt2 = (size_t)(blk - 16) * 512 + threadIdx.x, NT2 = (size_t)(G - 16) * 512;
            cvt_f32_bf16(args.in[I_CK], (bf16_t*)(ws + WS_CK), (size_t)NSB * NPAST * DM / 8, gt2, NT2);
            cvt_f32_bf16(args.in[I_CV], (bf16_t*)(ws + WS_CV), (size_t)NSB * NPAST * DM / 8, gt2, NT2);
        }
        xcd_barrier((unsigned*)(args.ws + WS_BAR), (volatile LAS unsigned*)(lds + LDS_BYTES - 64));
        ln_pass<1>(UB, nullptr, HB, args.in[I_LN1G], args.in[I_LN1B], (const float*)(ws + WS_WIF), (float*)(ws + WS_IF), TP, TT, 0, G);
    }
    SEAM(3);
    if (IN(4)) {
        pg8::Gemm g{}; g.A[0] = HB; g.Bt[0] = (const bf16_t*)(ws + WS_WML); g.M = TT; g.N = 7168; g.K = DM;
        pg8::StaticOrder S; S.init(TT, 7168, G, blk, 1);
        pg8::EpiSplitBf16 E{}; for (int i = 0; i < 5; ++i) E.dst[i] = (bf16_t*)(ws + WS_B0 + i * SZ1); E.dst[5] = (bf16_t*)U; E.dst[6] = (bf16_t*)U + (size_t)TT * DM;
        E.pk = args.out + O_PK; E.sk = args.out + O_SK; E.pv = args.out + O_PV; E.sv = args.out + O_SV; E.kt = 5; E.vt = 6;
        pg8::gemm_phase(lds, g, S, E);
    }
    SEAM(4);
    if (IN(5)) {
        for (int it = blk; it < 384; it += G) {
            int item = it;
            if (G == 256) {
                if (it < 256) { const int x = it & 7, j = it >> 3; item = ((x * 16 + (j >> 1)) << 1) | (j & 1); }
                else { const int sidx = it - 256, x = sidx & 7, j = sidx >> 3; item = 256 + (((x * 8 + (j >> 1)) << 1) | (j & 1)); }
            }
            ml::mlstm_item(args, lds, item);
        }
    }
    SEAM(5);
    if (IN(6)) {
        headln_pass((bf16_t*)(ws + WS_B0 + 2 * SZ1), (const bf16_t*)(ws + WS_B0 + 3 * SZ1), args.in[I_MLNG]);
    }
    if (IN(7)) {
        for (int u = blk; u < 4096 + 256; u += G) {
            if (u < 4096) { const int i = u >> 8, bb = u & 255, quad = i & 7, bh = (i >> 3) * 256 + bb; at::attn_unit(args, lds, false, bh >> 4, bh & 15, quad * 4, 4); }
            else { const int s = u - 4096; at::attn_unit(args, lds, true, s >> 4, s & 15, 8, 1); }
        }
    }
    SEAM(7);
    if (IN(8)) {
        pg8::Gemm g{}; g.A[0] = HB; g.A[1] = (const bf16_t*)(ws + WS_B0 + 2 * SZ1); g.A[2] = HB; g.A[3] = (const bf16_t*)(ws + WS_B0 + 4 * SZ1);
        g.Bt[0] = (const bf16_t*)(ws + WS_WGM); g.Bt[1] = (const bf16_t*)(ws + WS_WMLP); g.Bt[2] = (const bf16_t*)(ws + WS_WGA); g.Bt[3] = (const bf16_t*)(ws + WS_WATTP);
        g.M = TT; g.N = DM; g.K = DM;
        pg8::StaticOrder S; S.init(TP, DM, G, blk, 4);
        pg8::EpiMerge E{(bf16_t*)(ws + WS_B0), (u32x4*)(ws + WS_GSCR) + (size_t)blk * 48 * 512};
        pg8::gemm_phase(lds, g, S, E);
    }
    SEAM(8);
    if (IN(9)) {
        if (blk < 16) {
            pg8::Gemm g{}; g.A[0] = HB; g.A[1] = (const bf16_t*)(ws + WS_B0 + 2 * SZ1); g.A[2] = HB; g.A[3] = (const bf16_t*)(ws + WS_B0 + 4 * SZ1);
            g.Bt[0] = (const bf16_t*)(ws + WS_WGM); g.Bt[1] = (const bf16_t*)(ws + WS_WMLP); g.Bt[2] = (const bf16_t*)(ws + WS_WGA); g.Bt[3] = (const bf16_t*)(ws + WS_WATTP);
            g.M = TT; g.N = DM; g.K = DM;
            pg8::StaticOrder S; S.init(TS, DM, G, blk, 4, TP / 256);
            pg8::EpiMerge E{(bf16_t*)(ws + WS_B0), (u32x4*)(ws + WS_GSCR) + (size_t)blk * 48 * 512};
            pg8::gemm_phase(lds, g, S, E);
        } else {
            pg8::Gemm g{}; g.A[0] = (const bf16_t*)(ws + WS_B0); g.Bt[0] = (const bf16_t*)(ws + WS_WOUT); g.M = TT; g.N = DM; g.K = DM;
            pg8::StaticOrder S; S.init(TP, DM, G - 16, blk - 16, 1);
            pg8::EpiResid E{UB, nullptr, nullptr, HB, 1.0f, 1};
            pg8::gemm_phase(lds, g, S, E);
        }
    }
    SEAM(9);
    if (IN(10)) {
        if (blk < 16) {
            pg8::Gemm g{}; g.A[0] = (const bf16_t*)(ws + WS_B0); g.Bt[0] = (const bf16_t*)(ws + WS_WOUT); g.M = TT; g.N = DM; g.K = DM;
            pg8::StaticOrder S; S.init(TS, DM, G, blk, 1, TP / 256);
            pg8::EpiResid E{UB, nullptr, nullptr, HB, 1.0f, 1};
            pg8::gemm_phase(lds, g, S, E);
        } else {
            ln_pass<2>(UB, nullptr, HB, args.in[I_LN2G], args.in[I_LN2B], nullptr, nullptr, 0, TP, 16, G - 16);
        }
        xcd_barrier((unsigned*)(args.ws + WS_BAR), (volatile LAS unsigned*)(lds + LDS_BYTES - 64));
        ln_pass<2>(UB, nullptr, HB, args.in[I_LN2G], args.in[I_LN2B], nullptr, nullptr, TP, TT, 0, G);
    }
    SEAM(10);
    if (IN(11)) {
        pg8::Gemm g{}; g.A[0] = HB; g.Bt[0] = (const bf16_t*)(ws + WS_WGU2); g.M = TT; g.N = 2 * FF; g.K = DM;
        pg8::StaticOrder S; S.init(TT, 2 * FF, G, blk, 1);
        pg8::EpiSwiglu E{ACT};
        pg8::gemm_phase(lds, g, S, E);
        if ((DUP_MASK >> 11) & 1) pg8::gemm_phase(lds, g, S, E);
    }
    SEAM(11);
    if (IN(12)) {
        pg8::Gemm g{}; g.A[0] = ACT; g.Bt[0] = (const bf16_t*)(ws + WS_WD2); g.M = TT; g.N = DM; g.K = FF;
        pg8::StaticOrder S; S.init(TP, DM, G, blk, 1);
        pg8::EpiResid E{UB, nullptr, nullptr, HB, 0.5f, 1};
        pg8::gemm_phase(lds, g, S, E);
    }
    SEAM(12);
    if (IN(13)) {
        if (blk < 16) {
            pg8::Gemm g{}; g.A[0] = ACT; g.Bt[0] = (const bf16_t*)(ws + WS_WD2); g.M = TT; g.N = DM; g.K = FF;
            pg8::StaticOrder S; S.init(TS, DM, G, blk, 1, TP / 256);
            pg8::EpiResid E{UB, nullptr, nullptr, HB, 0.5f, 1};
            pg8::gemm_phase(lds, g, S, E);
        } else {
            ln_pass<3>(UB, U, nullptr, args.in[I_LN3G], args.in[I_LN3B], nullptr, nullptr, 0, TP, 16, G - 16);
        }
        xcd_barrier((unsigned*)(args.ws + WS_BAR), (volatile LAS unsigned*)(lds + LDS_BYTES - 64));
        ln_pass<3>(UB, U, nullptr, args.in[I_LN3G], args.in[I_LN3B], nullptr, nullptr, TP, TT, 0, G);
    }
#undef IN
#undef SEAM
}

extern "C" void kernel_launch(void* const* d_in, const int* in_sizes, int n_in, void* d_out, int out_size, void* d_ws, size_t ws_size, hipStream_t stream) {
    static int grid = 0;
    if (grid == 0) {
        if (n_in != 28 || ws_size < WS_END || (size_t)out_size != O_END) {
            fprintf(stderr, "kernel_launch: unexpected sizes n_in %d ws %zu (need %zu) out %d (expect %zu)\n", n_in, ws_size, (size_t)WS_END, out_size, (size_t)O_END);
            if (n_in != 28 || ws_size < WS_END) { grid = -1; return; }
        }
        (void)hipFuncSetAttribute((const void*)mega_fwd, hipFuncAttributeMaxDynamicSharedMemorySize, LDS_BYTES);
        int dev = 0, cus = 0, per_cu = 0;
        (void)hipGetDevice(&dev); (void)hipDeviceGetAttribute(&cus, hipDeviceAttributeMultiprocessorCount, dev);
        (void)hipOccupancyMaxActiveBlocksPerMultiprocessor(&per_cu, (const void*)mega_fwd, 512, LDS_BYTES);
        if (per_cu < 1) fprintf(stderr, "kernel_launch: occupancy query says %d blocks/CU\n", per_cu);
        (void)hipGetLastError();
        grid = cus > 0 ? cus : 256;
    }
    if (grid < 0) return;
    Args a{};
    for (int i = 0; i < 28; ++i) a.in[i] = (const float*)d_in[i];
    a.out = (float*)d_out; a.ws = (unsigned char*)d_ws;
#if MK_ONE_LAUNCH
    (void)hipMemsetAsync((char*)d_ws + WS_BAR, 0, 16384, stream);
    a.ph_lo = 0; a.ph_hi = NPHASE;
    void* kargs[] = {&a};
    hipError_t e = hipLaunchCooperativeKernel((const void*)mega_fwd, dim3(grid), dim3(512), kargs, LDS_BYTES, stream);
    if (e != hipSuccess) fprintf(stderr, "cooperative launch failed: %s (grid %d)\n", hipGetErrorString(e), grid);
#else
    for (int p = 0; p < NPHASE; ++p) { a.ph_lo = p; a.ph_hi = p + 1; hipLaunchKernelGGL(mega_fwd, dim3(grid), dim3(512), LDS_BYTES, stream, a); }
#endif
}
```

```cpp
#include <hip/hip_runtime.h>
#include <hip/hip_cooperative_groups.h>
#include <cstdio>
#include <cstdint>
namespace cg = cooperative_groups;

#ifndef MK_ONE_LAUNCH
#define MK_ONE_LAUNCH 1
#endif

#define LAS __attribute__((address_space(3)))
typedef unsigned short bf16_t;
typedef short bf16x8 __attribute__((ext_vector_type(8)));
typedef short s16x4 __attribute__((ext_vector_type(4)));
typedef float f32x4 __attribute__((ext_vector_type(4)));
typedef unsigned u32x4 __attribute__((ext_vector_type(4)));
typedef unsigned u32x2 __attribute__((ext_vector_type(2)));

constexpr int DM = 1024, TP = 65536, TS = 1024, TT = TP + TS, FF = 2816, SEQ = 2048, NB = 32, NSB = 16, DSEQ = 64, NPAST = 512;
constexpr int INW = 9224;
constexpr float ALPHA = 1.189207115002721f;
constexpr float LN_EPS = 1e-5f;
constexpr size_t MiB = 1u << 20;
constexpr size_t SZ1 = (size_t)TT * DM * 2;
constexpr size_t WS_WGU1 = 0, WS_WD1 = 11 * MiB, WS_WGU2 = 17 * MiB, WS_WD2 = 28 * MiB, WS_WML = 34 * MiB, WS_WATT = 42 * MiB,
                 WS_WGM = 48 * MiB, WS_WGA = 50 * MiB, WS_WMLP = 52 * MiB, WS_WATTP = 54 * MiB, WS_WOUT = 56 * MiB, WS_WIF = 58 * MiB, WS_IF = 59 * MiB, WS_BAR = 63 * MiB;
constexpr size_t WS_HB = 64 * MiB;
constexpr size_t WS_ACT = 194 * MiB;
constexpr size_t WS_B0 = 194 * MiB;
constexpr size_t WS_CK = WS_B0 + 5 * SZ1, WS_CV = WS_CK + 16 * MiB, WS_GSCR = WS_CV + 16 * MiB, WS_END = WS_GSCR + 96 * MiB;
static_assert(WS_END <= 1024 * MiB, "ws map");
constexpr size_t O_Y = 0, O_PCONV = (size_t)TT * DM, O_SCONV = O_PCONV + 32 * 3 * 2048, O_PC = O_SCONV + 16 * 3 * 2048, O_SC = O_PC + (size_t)32 * 4 * 65536,
                 O_PN = O_SC + (size_t)16 * 4 * 65536, O_SN = O_PN + 32 * 4 * 256, O_PM = O_SN + 16 * 4 * 256, O_SM = O_PM + 128, O_PK = O_SM + 64,
                 O_SK = O_PK + (size_t)32 * 512 * 1024, O_PV = O_SK + (size_t)16 * 64 * 1024, O_SV = O_PV + (size_t)32 * 512 * 1024, O_END = O_SV + (size_t)16 * 64 * 1024;

constexpr int LDS_BYTES = 147456;

__device__ __forceinline__ unsigned pk2(float lo, float hi) { unsigned r; asm volatile("v_cvt_pk_bf16_f32 %0, %1, %2" : "=v"(r) : "v"(lo), "v"(hi)); return r; }
__device__ __forceinline__ float bflo(unsigned w) { return __uint_as_float(w << 16); }
__device__ __forceinline__ float bfhi(unsigned w) { return __uint_as_float(w & 0xffff0000u); }
__device__ __forceinline__ float bf1(bf16_t b) { return __uint_as_float(((unsigned)b) << 16); }
__device__ __forceinline__ float rcpf_(float x) { return __builtin_amdgcn_rcpf(x); }
__device__ __forceinline__ float sigmoidf_(float x) { return __builtin_amdgcn_rcpf(1.0f + __expf(-x)); }
__device__ __forceinline__ float wave_sum(float v) {
#pragma unroll
    for (int o = 1; o < 64; o <<= 1) v += __shfl_xor(v, o);
    return v;
}
__device__ __forceinline__ s16x4 tr_read(const LAS unsigned char* p) {
    typedef short v4i16_t __attribute__((ext_vector_type(4)));
    return __builtin_bit_cast(s16x4, __builtin_amdgcn_ds_read_tr16_b64_v4i16((LAS v4i16_t*)p));
}


#define XB_TMO      128
#define XB_XCNT(j)  (256  + 64 * (j))
#define XB_XSUB(j)  (1280 + 64 * (j))
#define XB_XGEN(j)  (2304 + 64 * (j))
#define XB_TOP      3328
#define XB_TOPGEN   3392
#define XCD_BAR_WORDS 3456
#define XB_SPIN_CAP (1u << 22)
__device__ __forceinline__ unsigned xb_ld(unsigned* p)              { return __hip_atomic_load(p, __ATOMIC_RELAXED, __HIP_MEMORY_SCOPE_AGENT); }
__device__ __forceinline__ unsigned xb_add(unsigned* p, unsigned v) { return __hip_atomic_fetch_add(p, v, __ATOMIC_RELAXED, __HIP_MEMORY_SCOPE_AGENT); }
__device__ __forceinline__ unsigned xb_xcc_id() { return (unsigned)__builtin_amdgcn_s_getreg((3 << 11) | 20) & 0xFu; }
#define XB_SPIN(cond, bar) do { unsigned _sp = 0; while (cond) { __builtin_amdgcn_s_sleep(1); \
    if ((++_sp & 255u) == 0u) { if (xb_ld(&(bar)[XB_TMO])) break; if (_sp > XB_SPIN_CAP) { atomicAdd(&(bar)[XB_TMO], 1u); break; } } } } while (0)
struct XcdBarrier { unsigned* bar; unsigned x; volatile LAS unsigned* st; };
__device__ __forceinline__ XcdBarrier xcd_barrier_post(unsigned* bar, volatile LAS unsigned* st) {
    XcdBarrier b; b.bar = bar; b.x = xb_xcc_id(); b.st = st;
    if (threadIdx.x == 0) (void)xb_add(&bar[XB_XCNT(b.x)], 1u);
    return b;
}
__device__ __forceinline__ void xcd_barrier_complete(unsigned* bar, unsigned x, unsigned& nloc, unsigned& nx) {
    const unsigned G = gridDim.x * gridDim.y * gridDim.z;
    unsigned sum, cnt, mine, sp = 0u;
    for (;;) {
        sum = 0u; cnt = 0u; mine = 0u;
#pragma unroll
        for (unsigned j = 0; j < 16; ++j) { const unsigned c = xb_ld(&bar[XB_XCNT(j)]); sum += c; cnt += (c > 0u) ? 1u : 0u; mine = (j == x) ? c : mine; }
        if (sum == G) break;
        __builtin_amdgcn_s_sleep(1);
        if ((++sp & 255u) == 0u) { if (xb_ld(&bar[XB_TMO])) break; if (sp > XB_SPIN_CAP) { atomicAdd(&bar[XB_TMO], 1u); break; } }
    }
    nloc = mine > 0u ? mine : 1u; nx = cnt > 0u ? cnt : 1u;
}
__device__ __forceinline__ void xcd_barrier(unsigned* bar_, volatile LAS unsigned* st_) {
    XcdBarrier b; b.bar = bar_; b.st = st_; b.x = xb_xcc_id();
    asm volatile("s_waitcnt vmcnt(0)" ::: "memory");
    __syncthreads();
    if (threadIdx.x == 0) {
        unsigned* bar = b.bar;
        __builtin_amdgcn_s_waitcnt(0);
        unsigned nloc = b.st[0], nx = b.st[1];
        if (nloc == 0u) { xcd_barrier_complete(bar, b.x, nloc, nx); b.st[0] = nloc; b.st[1] = nx; }
        const unsigned old = xb_add(&bar[XB_XSUB(b.x)], 1u);
        const unsigned gen = old / nloc;
        if (old + 1u == (gen + 1u) * nloc) {
            __builtin_amdgcn_fence(__ATOMIC_RELEASE, "agent");
            asm volatile("s_waitcnt vmcnt(0)" ::: "memory");
            const unsigned og = xb_add(&bar[XB_TOP], 1u);
            const unsigned tg = og / nx;
            if (og + 1u == (tg + 1u) * nx) xb_add(&bar[XB_TOPGEN], 1u);
            else XB_SPIN(xb_ld(&bar[XB_TOPGEN]) == tg, bar);
            __builtin_amdgcn_fence(__ATOMIC_ACQUIRE, "agent");
            xb_add(&bar[XB_XGEN(b.x)], 1u);
            asm volatile("s_waitcnt vmcnt(0)" ::: "memory");
        } else {
            XB_SPIN(xb_ld(&bar[XB_XGEN(b.x)]) == gen, bar);
            __builtin_amdgcn_fence(__ATOMIC_ACQUIRE, "agent");
            asm volatile("s_waitcnt vmcnt(0)" ::: "memory");
        }
    }
    __syncthreads();
}

namespace pg8 {
constexpr int BM = 256, BK = 64, HALF = 128, HTB = HALF * BK * 2, STAGE_BYTES = 8 * HTB, NXCD = 8, WGM = 8;
__host__ __device__ __forceinline__ int lds_byte(int r, int c) { const int st = (r >> 4) * 2 + (c >> 5), rr = r & 15, cc = c & 31, ob = rr * 64 + cc * 2; return st * 1024 + (ob ^ (((ob >> 9) & 1) << 5)); }
__host__ __device__ __forceinline__ void stage_rc(int b, int& R, int& C) { const int st = b / 1024, sb = b % 1024, swz = sb ^ (((sb >> 9) & 1) << 5); R = (st >> 1) * 16 + swz / 64; C = (st & 1) * 32 + (swz % 64) / 2; }
__host__ __device__ __forceinline__ int perm32(int rho) { const int n = rho >> 4, i = rho & 15; return 8 * (i >> 2) + 4 * n + (i & 3); }

struct Unit { int pm, pn, seg; };
struct Gemm { const bf16_t* A[4]; const bf16_t* Bt[4]; int M, N, K;
    __device__ __forceinline__ const char* a(int sg) const { return (const char*)(sg == 0 ? A[0] : sg == 1 ? A[1] : sg == 2 ? A[2] : A[3]); }
    __device__ __forceinline__ const char* b(int sg) const { return (const char*)(sg == 0 ? Bt[0] : sg == 1 ? Bt[1] : sg == 2 ? Bt[2] : Bt[3]); } };

struct StaticOrder {
    int nM, nN, nwg, G, c, nseg, pm_off;
    __device__ void init(int M, int N, int G_, int c_, int nseg_, int pm_off_ = 0) { nM = M / BM; nN = N / BM; nwg = nM * nN; G = G_; c = c_; nseg = nseg_; pm_off = pm_off_; }
    __device__ bool next(int ii, Unit& u) const {
        const int i = ii / nseg; u.seg = ii - i * nseg;
        const long L = (long)i * G + c; if (L >= nwg) return false;
        int wgid = (int)L; { const int q = nwg / NXCD, r = nwg % NXCD, xcd = wgid % NXCD, off = wgid / NXCD; wgid = (xcd < r ? xcd * (q + 1) : r * (q + 1) + (xcd - r) * q) + off; }
        const int nig = WGM * nN, gid = wgid / nig, fm = gid * WGM, gsz = (nM - fm) < WGM ? (nM - fm) : WGM;
        u.pm = pm_off + fm + ((wgid % nig) % gsz); u.pn = (wgid % nig) / gsz; return true;
    }
};

template <class Epi, class Sched>
__device__ __forceinline__ void gemm_phase(LAS unsigned char* lds, const Gemm g, const Sched& S, const Epi& E) {
    const int tid = threadIdx.x, wid = __builtin_amdgcn_readfirstlane(tid >> 6), lane = tid & 63, wr = wid >> 2, wc = wid & 3, fr = lane & 15, fq = lane >> 4;
    const int K = g.K, nt = K / BK;
    unsigned voffA[2], voffB[2];
#pragma unroll
    for (int i = 0; i < 2; ++i) { int R, C; stage_rc(tid * 16 + i * 8192, R, C); const int Rb = Epi::PERM ? ((R & ~31) + perm32(R & 31)) : R;
        voffA[i] = (unsigned)(R * K + C) * 2u; voffB[i] = (unsigned)(Rb * K + C) * 2u; }
    const size_t kstep = (size_t)(BK * 2);
    const size_t hstep = (size_t)HALF * K * 2;
    const size_t tstep = 2 * hstep;
    const unsigned ldsw = (unsigned)wid * 1024u;
    const int aoff = lds_byte(wr * 64 + fr, fq * 8), boff = lds_byte(wc * 32 + fr, fq * 8);
#define PG8_SA(b, h) (((b) * 2 + (h)) * HTB)
#define PG8_SB(b, h) ((4 + (b) * 2 + (h)) * HTB)
#define PG8_STAGE(bufoff, gbase, voff) do { _Pragma("unroll") for (int _i = 0; _i < 2; ++_i) \
        __builtin_amdgcn_global_load_lds((const unsigned*)((const char*)(gbase) + (voff)[_i]), (LAS unsigned*)(lds + (bufoff) + ldsw + _i * 8192), 16, 0, 0); } while (0)
#define PG8_LDA(dst, b, h) do { _Pragma("unroll") for (int m = 0; m < 4; ++m) _Pragma("unroll") for (int k = 0; k < 2; ++k) dst[m][k] = *(const LAS bf16x8*)(lds + PG8_SA(b, h) + aoff + m * 2048 + k * 1024); } while (0)
#define PG8_LDB(dst, b, h) do { _Pragma("unroll") for (int n = 0; n < 2; ++n) _Pragma("unroll") for (int k = 0; k < 2; ++k) dst[n][k] = *(const LAS bf16x8*)(lds + PG8_SB(b, h) + boff + n * 2048 + k * 1024); } while (0)
#define PG8_MMA(ai, bj, At, Bt) do { __builtin_amdgcn_s_setprio(1); _Pragma("unroll") for (int m = 0; m < 4; ++m) _Pragma("unroll") for (int n = 0; n < 2; ++n) _Pragma("unroll") for (int k = 0; k < 2; ++k) \
        acc[ai][bj][m][n] = __builtin_amdgcn_mfma_f32_16x16x32_bf16(Bt[n][k], At[m][k], acc[ai][bj][m][n], 0, 0, 0); __builtin_amdgcn_s_setprio(0); } while (0)
#define PG8_WAIT_V(n) asm volatile("s_waitcnt vmcnt(" #n ")" ::: "memory")
#define PG8_WAIT_L(n) asm volatile("s_waitcnt lgkmcnt(" #n ")" ::: "memory")
#define PG8_BAR __builtin_amdgcn_s_barrier()
#define PG8_SCHED __builtin_amdgcn_sched_barrier(0)
    Unit cur, nxt; int ui = 0;
    if (!S.next(0, cur)) return;
    f32x4 acc[2][2][4][2];
#pragma unroll
    for (int a = 0; a < 2; ++a)
#pragma unroll
        for (int b = 0; b < 2; ++b)
#pragma unroll
            for (int m = 0; m < 4; ++m)
#pragma unroll
                for (int n = 0; n < 2; ++n) acc[a][b][m][n] = (f32x4){0.f, 0.f, 0.f, 0.f};
    bf16x8 At[4][2], B0[2][2], B1[2][2];
    const char* cA = g.a(cur.seg) + (size_t)cur.pm * tstep; const char* cB = g.b(cur.seg) + (size_t)cur.pn * tstep;
    PG8_STAGE(PG8_SB(0, 0), cB, voffB); PG8_STAGE(PG8_SB(0, 1), cB + hstep, voffB); PG8_STAGE(PG8_SA(0, 0), cA, voffA); PG8_STAGE(PG8_SA(0, 1), cA + hstep, voffA);
    if (wr == 1) PG8_BAR;
    PG8_WAIT_V(2); PG8_BAR;
    PG8_STAGE(PG8_SB(1, 0), cB + kstep, voffB); PG8_STAGE(PG8_SA(1, 0), cA + kstep, voffA); PG8_STAGE(PG8_SB(1, 1), cB + hstep + kstep, voffB);
    PG8_WAIT_V(6); PG8_BAR;
    for (;;) {
        const bool has_next = S.next(ui + 1, nxt);
        const char* nA = has_next ? g.a(nxt.seg) + (size_t)nxt.pm * tstep : cA; const char* nB = has_next ? g.b(nxt.seg) + (size_t)nxt.pn * tstep : cB;
        for (int t = 0; t < nt; t += 2) {
            const bool last = (t == nt - 2);
            const char* a1 = cA + (size_t)(t + 1) * kstep;
            const char* a2 = last ? nA : cA + (size_t)(t + 2) * kstep; const char* b2 = last ? nB : cB + (size_t)(t + 2) * kstep;
            const char* a3 = a2 + kstep; const char* b3 = b2 + kstep;
            PG8_LDB(B0, 0, 0); PG8_LDB(B1, 0, 1); PG8_SCHED; PG8_LDA(At, 0, 0); PG8_STAGE(PG8_SA(1, 1), a1 + hstep, voffA);
            PG8_WAIT_V(8); PG8_WAIT_L(0); PG8_BAR; PG8_MMA(0, 0, At, B0); PG8_MMA(0, 1, At, B1); PG8_BAR; PG8_SCHED;
            PG8_LDA(At, 0, 1); PG8_STAGE(PG8_SB(0, 0), b2, voffB); PG8_STAGE(PG8_SB(0, 1), b2 + hstep, voffB); PG8_STAGE(PG8_SA(0, 0), a2, voffA);
            PG8_WAIT_V(8); PG8_WAIT_L(0); PG8_BAR; PG8_MMA(1, 0, At, B0); PG8_MMA(1, 1, At, B1); PG8_BAR; PG8_SCHED;
            PG8_LDB(B0, 1, 0); PG8_LDB(B1, 1, 1); PG8_SCHED; PG8_LDA(At, 1, 0); PG8_STAGE(PG8_SA(0, 1), a2 + hstep, voffA);
            PG8_WAIT_V(8); PG8_WAIT_L(0); PG8_BAR; PG8_MMA(0, 0, At, B0); PG8_MMA(0, 1, At, B1); PG8_BAR; PG8_SCHED;
            PG8_LDA(At, 1, 1); PG8_STAGE(PG8_SB(1, 0), b3, voffB); PG8_STAGE(PG8_SB(1, 1), b3 + hstep, voffB); PG8_STAGE(PG8_SA(1, 0), a3, voffA);
            PG8_WAIT_V(8); PG8_WAIT_L(0); PG8_BAR; PG8_MMA(1, 0, At, B0); PG8_MMA(1, 1, At, B1); PG8_BAR; PG8_SCHED;
        }
        if (wr == 0) PG8_BAR;
        E(acc, cur, wr, wc, fr, fq);
        if (!has_next) break;
        if (!(Epi::KEEP && E.keep(cur))) {
#pragma unroll
            for (int a = 0; a < 2; ++a)
#pragma unroll
                for (int b = 0; b < 2; ++b)
#pragma unroll
                    for (int m = 0; m < 4; ++m)
#pragma unroll
                        for (int n = 0; n < 2; ++n) acc[a][b][m][n] = (f32x4){0.f, 0.f, 0.f, 0.f};
        }
        cur = nxt; cA = nA; cB = nB; ++ui;
        if (wr == 1) PG8_BAR;
    }
    PG8_WAIT_V(0);
    PG8_BAR;
#undef PG8_SA
#undef PG8_SB
#undef PG8_STAGE
#undef PG8_LDA
#undef PG8_LDB
#undef PG8_MMA
#undef PG8_WAIT_V
#undef PG8_WAIT_L
#undef PG8_BAR
#undef PG8_SCHED
}

struct EpiSwiglu {
    static constexpr bool PERM = true, KEEP = false;
    bf16_t* O;
    __device__ __forceinline__ bool keep(const Unit&) const { return false; }
    __device__ __forceinline__ void operator()(f32x4 (&acc)[2][2][4][2], const Unit& u, int wr, int wc, int fr, int fq) const {
        const int row0 = u.pm * BM + wr * 64 + fr, col0 = u.pn * 128 + wc * 32 + 8 * fq;
#pragma unroll
        for (int ai = 0; ai < 2; ++ai)
#pragma unroll
            for (int m = 0; m < 4; ++m) {
                bf16_t* rowp = O + (size_t)(row0 + ai * HALF + m * 16) * FF + col0;
                float v[8];
#pragma unroll
                for (int n = 0; n < 2; ++n)
#pragma unroll
                    for (int i = 0; i < 4; ++i) { const float gt = acc[ai][0][m][n][i], up = acc[ai][1][m][n][i]; v[n * 4 + i] = gt * sigmoidf_(gt) * up; }
                u32x4 w; w.x = pk2(v[0], v[1]); w.y = pk2(v[2], v[3]); w.z = pk2(v[4], v[5]); w.w = pk2(v[6], v[7]);
                *(u32x4*)rowp = w;
            }
    }
};
struct EpiResid {
    static constexpr bool PERM = false, KEEP = false;
    bf16_t* U; const float* xp; const float* xs; const bf16_t* hb; float scale; int mode;
    __device__ __forceinline__ bool keep(const Unit&) const { return false; }
    __device__ __forceinline__ void operator()(f32x4 (&acc)[2][2][4][2], const Unit& u, int wr, int wc, int fr, int fq) const {
        const int row0 = u.pm * BM + wr * 64 + fr, col0 = u.pn * BM + wc * 32 + 4 * fq;
#pragma unroll
        for (int ai = 0; ai < 2; ++ai)
#pragma unroll
            for (int m = 0; m < 4; ++m) {
                const int r = row0 + ai * HALF + m * 16;
                bf16_t* op = U + (size_t)r * DM;
                if (mode == 0) {
                    const float* bp = (r < TP ? xp + (size_t)r * DM : xs + (size_t)(r - TP) * DM);
#pragma unroll
                    for (int bj = 0; bj < 2; ++bj)
#pragma unroll
                        for (int n = 0; n < 2; ++n) { const int c = col0 + bj * HALF + n * 16; const f32x4 b = *(const f32x4*)(bp + c); const f32x4 o = b * ALPHA + acc[ai][bj][m][n] * scale; *(u32x2*)(op + c) = (u32x2){pk2(o[0], o[1]), pk2(o[2], o[3])}; }
                } else {
                    const bf16_t* bp = hb + (size_t)r * DM;
#pragma unroll
                    for (int bj = 0; bj < 2; ++bj)
#pragma unroll
                        for (int n = 0; n < 2; ++n) { const int c = col0 + bj * HALF + n * 16; const u32x2 w = *(const u32x2*)(bp + c);
                            const f32x4 b = (f32x4){bflo(w.x), bfhi(w.x), bflo(w.y), bfhi(w.y)}; const f32x4 o = b * ALPHA + acc[ai][bj][m][n] * scale; *(u32x2*)(op + c) = (u32x2){pk2(o[0], o[1]), pk2(o[2], o[3])}; }
                }
            }
    }
};
struct EpiSplitBf16 {
    static constexpr bool PERM = true, KEEP = false;
    bf16_t* dst[7]; float* pk; float* sk; float* pv; float* sv; int kt, vt;
    __device__ __forceinline__ bool keep(const Unit&) const { return false; }
    __device__ __forceinline__ void operator()(f32x4 (&acc)[2][2][4][2], const Unit& u, int wr, int wc, int fr, int fq) const {
        const int t = u.pn >> 2; bf16_t* base = (t == 0 ? dst[0] : t == 1 ? dst[1] : t == 2 ? dst[2] : t == 3 ? dst[3] : t == 4 ? dst[4] : t == 5 ? dst[5] : dst[6]);
        const int row0 = u.pm * BM + wr * 64 + fr, col0 = (u.pn & 3) * BM + wc * 32 + 8 * fq;
        float* fbase = nullptr;
        if (t == kt || t == vt) {
            if (u.pm >= 256) fbase = (t == kt ? sk : sv) + (size_t)(u.pm * BM - TP) * DM;
            else if ((u.pm & 7) >= 6) fbase = (t == kt ? pk : pv) + ((size_t)(u.pm >> 3) * 512 + (size_t)((u.pm & 7) - 6) * 256) * DM;
        }
#pragma unroll
        for (int ai = 0; ai < 2; ++ai)
#pragma unroll
            for (int m = 0; m < 4; ++m) {
                const int r = row0 + ai * HALF + m * 16;
                bf16_t* rowp = base + (size_t)r * DM + col0;
#pragma unroll
                for (int bj = 0; bj < 2; ++bj) {
                    const f32x4 v0 = acc[ai][bj][m][0], v1 = acc[ai][bj][m][1];
                    u32x4 w; w.x = pk2(v0[0], v0[1]); w.y = pk2(v0[2], v0[3]); w.z = pk2(v1[0], v1[1]); w.w = pk2(v1[2], v1[3]);
                    *(u32x4*)(rowp + bj * HALF) = w;
                    if (fbase) { float* fp = fbase + (size_t)(r - u.pm * BM) * DM + col0 + bj * HALF; *(f32x4*)fp = v0; *(f32x4*)(fp + 4) = v1; }
                }
            }
    }
};
struct EpiMerge {
    static constexpr bool PERM = true, KEEP = false;
    bf16_t* MG; u32x4* scr;
    __device__ __forceinline__ bool keep(const Unit&) const { return false; }
    __device__ __forceinline__ void operator()(const f32x4 (&acc)[2][2][4][2], const Unit& u, int wr, int wc, int fr, int fq) const {
        const int tid = threadIdx.x;
        const int row0 = u.pm * BM + wr * 64 + fr, col0 = u.pn * BM + wc * 32 + 8 * fq;
#define PINP(x) asm volatile("" : "+v"(x))
        if (u.seg == 0 || u.seg == 2) {
            int qa = tid; PINP(qa);
#pragma unroll
            for (int k = 0; k < 16; ++k) {
                const f32x4 v0 = acc[k >> 3][k & 1][(k >> 1) & 3][0], v1 = acc[k >> 3][k & 1][(k >> 1) & 3][1];
                u32x4 w; w.x = pk2(sigmoidf_(v0[0]), sigmoidf_(v0[1])); w.y = pk2(sigmoidf_(v0[2]), sigmoidf_(v0[3]));
                w.z = pk2(sigmoidf_(v1[0]), sigmoidf_(v1[1])); w.w = pk2(sigmoidf_(v1[2]), sigmoidf_(v1[3]));
                scr[qa] = w; qa += 512; PINP(qa);
            }
        } else if (u.seg == 1) {
            int qa = tid, qc = tid + 16 * 512; PINP(qa); PINP(qc);
#pragma unroll
            for (int k = 0; k < 16; ++k) {
                const f32x4 v0 = acc[k >> 3][k & 1][(k >> 1) & 3][0], v1 = acc[k >> 3][k & 1][(k >> 1) & 3][1];
                const u32x4 a = scr[qa];
                const f32x4 c0 = (f32x4){v0[0] * bflo(a.x), v0[1] * bfhi(a.x), v0[2] * bflo(a.y), v0[3] * bfhi(a.y)};
                const f32x4 c1 = (f32x4){v1[0] * bflo(a.z), v1[1] * bfhi(a.z), v1[2] * bflo(a.w), v1[3] * bfhi(a.w)};
                scr[qc] = (u32x4){pk2(c0[0], c0[1]), pk2(c0[2], c0[3]), pk2(c1[0], c1[1]), pk2(c1[2], c1[3])};
                qa += 512; qc += 512; PINP(qa); PINP(qc);
            }
        } else {
            int qa = tid, qc = tid + 16 * 512; PINP(qa); PINP(qc);
            int mo = row0 * DM + col0; PINP(mo);
#pragma unroll
            for (int k = 0; k < 16; ++k) {
                const int ai = k >> 3, bj = k & 1, m = (k >> 1) & 3;
                const f32x4 v0 = acc[ai][bj][m][0], v1 = acc[ai][bj][m][1];
                const u32x4 b = scr[qa];
                const u32x4 cw = scr[qc];
                const f32x4 c0 = (f32x4){bflo(cw.x), bfhi(cw.x), bflo(cw.y), bfhi(cw.y)}, c1 = (f32x4){bflo(cw.z), bfhi(cw.z), bflo(cw.w), bfhi(cw.w)};
                u32x4 w; w.x = pk2(c0[0] + v0[0] * bflo(b.x), c0[1] + v0[1] * bfhi(b.x)); w.y = pk2(c0[2] + v0[2] * bflo(b.y), c0[3] + v0[3] * bfhi(b.y));
                w.z = pk2(c1[0] + v1[0] * bflo(b.z), c1[1] + v1[1] * bfhi(b.z)); w.w = pk2(c1[2] + v1[2] * bflo(b.w), c1[3] + v1[3] * bfhi(b.w));
                *(u32x4*)(MG + mo + (ai * HALF + m * 16) * DM + bj * HALF) = w;
                qa += 512; qc += 512; PINP(qa); PINP(qc);
            }
        }
#undef PINP
    }
};
}

struct Args {
    const float* in[28];
    float* out; unsigned char* ws;
    int ph_lo, ph_hi;
};
enum { I_XP = 0, I_XS, I_SCONV, I_SC, I_SN, I_SM, I_CK, I_CV, I_WIN, I_BI, I_BF, I_CONVW, I_CONVB, I_MLNG, I_RELB, I_WMLP, I_WATTP, I_WOUT,
       I_GU1, I_D1, I_GU2, I_D2, I_LN1G, I_LN1B, I_LN2G, I_LN2B, I_LN3G, I_LN3B };

__device__ __forceinline__ void transpose_item(const float* W, int ldw, int col0, int K, int N, bf16_t* WT, int mode, LAS float* scr, int item, int lane) {
    const int nblk = N / 32, kb = item / nblk, nb = item % nblk, k0 = 64 * kb, n0 = 32 * nb;
    {
        const int n4 = (lane & 7) * 4, kq = lane >> 3;
        f32x4 wv[8];
#pragma unroll
        for (int i = 0; i < 8; ++i) wv[i] = *(const f32x4*)(W + (size_t)(k0 + kq + 8 * i) * ldw + col0 + n0 + n4);
#pragma unroll
        for (int i = 0; i < 8; ++i) { LAS float* d = scr + (kq + 8 * i) * 33 + n4; d[0] = wv[i][0]; d[1] = wv[i][1]; d[2] = wv[i][2]; d[3] = wv[i][3]; }
    }
    asm volatile("s_waitcnt lgkmcnt(0)" ::: "memory");
    const int c = lane & 7;
#pragma unroll
    for (int j = 0; j < 4; ++j) { const int nn = (lane >> 3) + 8 * j; const LAS float* s = scr + (8 * c) * 33 + nn;
        u32x4 o; o.x = pk2(s[0 * 33], s[1 * 33]); o.y = pk2(s[2 * 33], s[3 * 33]); o.z = pk2(s[4 * 33], s[5 * 33]); o.w = pk2(s[6 * 33], s[7 * 33]);
        const int n = n0 + nn;
        const int drow = (mode == 1) ? (256 * ((n % FF) / 128) + 128 * (n / FF) + (n % 128)) : n;
        *(u32x4*)(WT + (size_t)drow * K + k0 + 8 * c) = o; }
    asm volatile("s_waitcnt lgkmcnt(0)" ::: "memory");
}
__device__ __forceinline__ void cvt_f32_bf16(const float* src, bf16_t* dst, size_t n8, size_t i0, size_t stride) {
    for (size_t i = i0; i < n8; i += stride) {
        const f32x4 a = *(const f32x4*)(src + i * 8), b = *(const f32x4*)(src + i * 8 + 4);
        u32x4 w; w.x = pk2(a[0], a[1]); w.y = pk2(a[2], a[3]); w.z = pk2(b[0], b[1]); w.w = pk2(b[2], b[3]);
        *(u32x4*)(dst + i * 8) = w;
    }
}
__device__ __forceinline__ void p0_prologue(const Args& a, LAS unsigned char* lds) {
    const int tid = threadIdx.x, lane = tid & 63, wave = tid >> 6;
    LAS float* scr = (LAS float*)(lds + wave * 16384);
    const int gw = blockIdx.x * 8 + wave, NGW = gridDim.x * 8;
    unsigned char* ws = a.ws;
    constexpr int I_GU = (DM / 64) * (2 * FF / 32), I_DN = (FF / 64) * (DM / 32), I_ML = (DM / 64) * (4096 / 32), I_AT = (DM / 64) * (3072 / 32), I_SQ = (DM / 64) * (DM / 32);
    constexpr int NITEMS = 2 * I_GU + 2 * I_DN + I_ML + I_AT + 5 * I_SQ;
    for (int it = gw; it < NITEMS; it += NGW) {
        int r = it;
        if (r < I_GU) { transpose_item(a.in[I_GU1], 2 * FF, 0, DM, 2 * FF, (bf16_t*)(ws + WS_WGU1), 1, scr, r, lane); continue; } r -= I_GU;
        if (r < I_GU) { transpose_item(a.in[I_GU2], 2 * FF, 0, DM, 2 * FF, (bf16_t*)(ws + WS_WGU2), 1, scr, r, lane); continue; } r -= I_GU;
        if (r < I_DN) { transpose_item(a.in[I_D1], DM, 0, FF, DM, (bf16_t*)(ws + WS_WD1), 0, scr, r, lane); continue; } r -= I_DN;
        if (r < I_DN) { transpose_item(a.in[I_D2], DM, 0, FF, DM, (bf16_t*)(ws + WS_WD2), 0, scr, r, lane); continue; } r -= I_DN;
        if (r < I_ML) { transpose_item(a.in[I_WIN], INW, 0, DM, 4096, (bf16_t*)(ws + WS_WML), 0, scr, r, lane); continue; } r -= I_ML;
        if (r < I_AT) { transpose_item(a.in[I_WIN], INW, 4104, DM, 3072, (bf16_t*)(ws + WS_WATT), 0, scr, r, lane); continue; } r -= I_AT;
        if (r < I_SQ) { transpose_item(a.in[I_WIN], INW, 7176, DM, DM, (bf16_t*)(ws + WS_WGM), 0, scr, r, lane); continue; } r -= I_SQ;
        if (r < I_SQ) { transpose_item(a.in[I_WIN], INW, 8200, DM, DM, (bf16_t*)(ws + WS_WGA), 0, scr, r, lane); continue; } r -= I_SQ;
        if (r < I_SQ) { transpose_item(a.in[I_WMLP], DM, 0, DM, DM, (bf16_t*)(ws + WS_WMLP), 0, scr, r, lane); continue; } r -= I_SQ;
        if (r < I_SQ) { transpose_item(a.in[I_WATTP], DM, 0, DM, DM, (bf16_t*)(ws + WS_WATTP), 0, scr, r, lane); continue; } r -= I_SQ;
        transpose_item(a.in[I_WOUT], DM, 0, DM, DM, (bf16_t*)(ws + WS_WOUT), 0, scr, r, lane);
    }
    const size_t gt = (size_t)blockIdx.x * 512 + tid, NT = (size_t)gridDim.x * 512;
    for (size_t i = gt; i < 8 * 1024; i += NT) { const int c = (int)(i >> 10), k = (int)(i & 1023); ((float*)(ws + WS_WIF))[i] = a.in[I_WIN][(size_t)k * INW + 4096 + c]; }
    cvt_f32_bf16(a.in[I_XP], (bf16_t*)(ws + WS_HB), (size_t)TP * DM / 8, gt, NT);
    cvt_f32_bf16(a.in[I_XS], (bf16_t*)(ws + WS_HB) + (size_t)TP * DM, (size_t)TS * DM / 8, gt, NT);
}

template <int MODE>
__device__ __forceinline__ void ln_pass(const bf16_t* Ub, float* Yout, bf16_t* HB, const float* g, const float* bta, const float* WIF, float* IFo, int row_lo, int row_hi, int cu_lo, int ncu) {
    int tid = threadIdx.x; asm volatile("" : "+v"(tid)); const int lane = tid & 63, wave = tid >> 6;
    const int gw = ((int)blockIdx.x - cu_lo) * 8 + wave, NGW = ncu * 8;
    if (gw < 0 || gw >= NGW) return;
    constexpr int R = 2;
    f32x4 gg[4], bb[4];
#pragma unroll
    for (int j = 0; j < 4; ++j) { gg[j] = *(const f32x4*)(g + 4 * lane + 256 * j); bb[j] = *(const f32x4*)(bta + 4 * lane + 256 * j); }
    f32x4 wif[MODE == 1 ? 8 : 1][4];
    if (MODE == 1) {
#pragma unroll
        for (int c = 0; c < 8; ++c)
#pragma unroll
            for (int j = 0; j < 4; ++j) wif[c][j] = *(const f32x4*)(WIF + c * 1024 + 4 * lane + 256 * j);
    }
    for (int row0 = row_lo + gw * R; row0 < row_hi; row0 += NGW * R) {
        f32x4 v[R][4]; float s[R], s2[R];
#pragma unroll
        for (int r = 0; r < R; ++r) {
            const bf16_t* ur = Ub + (size_t)(row0 + r) * DM + 4 * lane;
#pragma unroll
            for (int j = 0; j < 4; ++j) { const u32x2 w = *(const u32x2*)(ur + 256 * j); v[r][j] = (f32x4){bflo(w.x), bfhi(w.x), bflo(w.y), bfhi(w.y)}; }
        }
#pragma unroll
        for (int r = 0; r < R; ++r) { s[r] = 0.f;
#pragma unroll
            for (int j = 0; j < 4; ++j) s[r] += (v[r][j][0] + v[r][j][1]) + (v[r][j][2] + v[r][j][3]); }
#pragma unroll
        for (int o = 1; o < 64; o <<= 1) {
#pragma unroll
            for (int r = 0; r < R; ++r) s[r] += __shfl_xor(s[r], o); }
#pragma unroll
        for (int r = 0; r < R; ++r) { const float mean = s[r] * (1.f / DM); s2[r] = 0.f;
#pragma unroll
            for (int j = 0; j < 4; ++j) { v[r][j] = v[r][j] - mean; s2[r] += (v[r][j][0] * v[r][j][0] + v[r][j][1] * v[r][j][1]) + (v[r][j][2] * v[r][j][2] + v[r][j][3] * v[r][j][3]); } }
#pragma unroll
        for (int o = 1; o < 64; o <<= 1) {
#pragma unroll
            for (int r = 0; r < R; ++r) s2[r] += __shfl_xor(s2[r], o); }
#pragma unroll
        for (int r = 0; r < R; ++r) {
            const float rstd = 1.f / sqrtf(s2[r] * (1.f / DM) + LN_EPS);
#pragma unroll
            for (int j = 0; j < 4; ++j) v[r][j] = v[r][j] * rstd * gg[j] + bb[j];
            if (MODE == 3) {
                float* ur = Yout + (size_t)(row0 + r) * DM + 4 * lane;
#pragma unroll
                for (int j = 0; j < 4; ++j) *(f32x4*)(ur + 256 * j) = v[r][j];
            } else {
                bf16_t* hr = HB + (size_t)(row0 + r) * DM + 4 * lane;
#pragma unroll
                for (int j = 0; j < 4; ++j) { u32x2 w; w.x = pk2(v[r][j][0], v[r][j][1]); w.y = pk2(v[r][j][2], v[r][j][3]); *(u32x2*)(hr + 256 * j) = w; }
            }
        }
        if (MODE == 1) {
#pragma unroll
            for (int r = 0; r < R; ++r) {
                float d[8];
#pragma unroll
                for (int c = 0; c < 8; ++c) { d[c] = 0.f;
#pragma unroll
                    for (int j = 0; j < 4; ++j) { const f32x4 w = wif[MODE == 1 ? c : 0][j]; d[c] += (v[r][j][0] * w[0] + v[r][j][1] * w[1]) + (v[r][j][2] * w[2] + v[r][j][3] * w[3]); } }
                const bool b0 = lane & 1, b1 = lane & 2, b2 = lane & 4;
                float e[4], f[2], hsum;
#pragma unroll
                for (int i = 0; i < 4; ++i) { const float t_ = __shfl_xor(b0 ? d[i] : d[i + 4], 1); e[i] = (b0 ? d[i + 4] : d[i]) + t_; }
#pragma unroll
                for (int i = 0; i < 2; ++i) { const float t_ = __shfl_xor(b1 ? e[i] : e[i + 2], 2); f[i] = (b1 ? e[i + 2] : e[i]) + t_; }
                { const float t_ = __shfl_xor(b2 ? f[0] : f[1], 4); hsum = (b2 ? f[1] : f[0]) + t_; }
                hsum += __shfl_xor(hsum, 8); hsum += __shfl_xor(hsum, 16); hsum += __shfl_xor(hsum, 32);
                const int col = (b0 ? 4 : 0) + (b1 ? 2 : 0) + (b2 ? 1 : 0);
                if (lane < 8) IFo[(size_t)(row0 + r) * 8 + col] = hsum;
            }
        }
    }
}

__device__ __forceinline__ void headln_pass(bf16_t* H, const bf16_t* MLO, const float* ng) {
    int tid = threadIdx.x; asm volatile("" : "+v"(tid)); const int lane = tid & 63, wave = tid >> 6;
    const int gw = blockIdx.x * 8 + wave, NGW = gridDim.x * 8;
    const int c0 = (lane >> 4) * 256 + (lane & 15) * 16;
    float gv[16];
#pragma unroll
    for (int i = 0; i < 16; ++i) gv[i] = ng[c0 + i];
    for (int rowb = gw; rowb < TT; rowb += 2 * NGW) {
        u32x4 a0[2], a1[2], o0[2], o1[2];
#pragma unroll
        for (int q = 0; q < 2; ++q) {
            const int row = (rowb + q * NGW < TT) ? rowb + q * NGW : rowb;
            a0[q] = *(const u32x4*)(H + (size_t)row * DM + c0); a1[q] = *(const u32x4*)(H + (size_t)row * DM + c0 + 8);
            o0[q] = *(const u32x4*)(MLO + (size_t)row * DM + c0); o1[q] = *(const u32x4*)(MLO + (size_t)row * DM + c0 + 8);
        }
#pragma unroll
        for (int q = 0; q < 2; ++q) {
            const int row = rowb + q * NGW;
            float v[16], og[16];
            const unsigned aw[8] = {a0[q].x, a0[q].y, a0[q].z, a0[q].w, a1[q].x, a1[q].y, a1[q].z, a1[q].w}, ow[8] = {o0[q].x, o0[q].y, o0[q].z, o0[q].w, o1[q].x, o1[q].y, o1[q].z, o1[q].w};
#pragma unroll
            for (int i = 0; i < 8; ++i) { v[2 * i] = bflo(aw[i]); v[2 * i + 1] = bfhi(aw[i]); og[2 * i] = bflo(ow[i]); og[2 * i + 1] = bfhi(ow[i]); }
            float sm = 0.f;
#pragma unroll
            for (int i = 0; i < 16; ++i) sm += v[i];
#pragma unroll
            for (int o = 1; o < 16; o <<= 1) sm += __shfl_xor(sm, o);
            const float mean = sm * (1.f / 256.f); float s2 = 0.f;
#pragma unroll
            for (int i = 0; i < 16; ++i) { v[i] -= mean; s2 += v[i] * v[i]; }
#pragma unroll
            for (int o = 1; o < 16; o <<= 1) s2 += __shfl_xor(s2, o);
            const float rstd = 1.f / sqrtf(s2 * (1.f / 256.f) + LN_EPS);
            unsigned w[8];
#pragma unroll
            for (int i = 0; i < 8; ++i) w[i] = pk2(v[2 * i] * rstd * gv[2 * i] * sigmoidf_(og[2 * i]), v[2 * i + 1] * rstd * gv[2 * i + 1] * sigmoidf_(og[2 * i + 1]));
            if (row < TT) {
                *(u32x4*)(H + (size_t)row * DM + c0) = (u32x4){w[0], w[1], w[2], w[3]};
                *(u32x4*)(H + (size_t)row * DM + c0 + 8) = (u32x4){w[4], w[5], w[6], w[7]};
            }
        }
    }
}

namespace ml {
constexpr int QS = 0, KS = 35840, VS = 71680, VW = 91136, PS = 110592, CW = 119808, NV = 130048, SC = 131072;
constexpr int QROW = 560, VROW = 304, PROW = 144;
constexpr int S_A = 0, S_PM = 256, S_WI = 512, S_EMT = 768, S_WS = 1024, S_RS0 = 1280, S_RS1 = 1536, S_QN = 1792, S_DEC = 2048, S_PAR = 2304;
static_assert(KS - QS >= 64 * QROW && VS - KS >= 64 * QROW && VW - VS >= 64 * VROW && PS - VW >= 64 * VROW && CW - PS >= 64 * PROW && NV - CW >= 10240 && SC - NV >= 1024 && SC + 2 * S_PAR <= LDS_BYTES - 64, "mlstm lds");

__device__ __forceinline__ void mlstm_item(const Args& a, LAS unsigned char* lds, int item) {
    const int tid = threadIdx.x, lane = tid & 63, wid = __builtin_amdgcn_readfirstlane(tid >> 6), fr = lane & 15, g = lane >> 4;
    const bool sample = item >= 256; const int it = sample ? item - 256 : item;
    const int b = it >> 3, h = (it >> 1) & 3, half = it & 1;
    const int row0 = sample ? TP + b * DSEQ : b * SEQ, nch = sample ? 1 : SEQ / 64;
    unsigned char* ws = a.ws;
    const bf16_t* MLQ = (const bf16_t*)(ws + WS_B0); const bf16_t* MLK = (const bf16_t*)(ws + WS_B0 + SZ1); const bf16_t* MLV = (const bf16_t*)(ws + WS_B0 + 2 * SZ1);
    const float* IFb = (const float*)(ws + WS_IF);
    float* out = a.out;
    const int e0 = 16 * wid;
    const int ecol = h * 256 + half * 128;
    LAS float* cw = (LAS float*)(lds + CW);
    for (int i = tid; i < 2 * 5 * 256; i += 512) { const int mat = i / 1280, r = (i % 1280) / 256, ch = i & 255; const int gc = mat * 1024 + h * 256 + ch;
        cw[i] = (r < 4) ? a.in[I_CONVW][r * 2048 + gc] : a.in[I_CONVB][gc]; }
    LAS float* nv = (LAS float*)(lds + NV);
    if (tid < 256) nv[tid] = sample ? a.in[I_SN][(b * 4 + h) * 256 + tid] : 0.f;
    f32x4 accC[16];
#pragma unroll
    for (int dt = 0; dt < 16; ++dt) accC[dt] = (f32x4){0.f, 0.f, 0.f, 0.f};
    if (sample) {
#pragma unroll
        for (int dt = 0; dt < 16; ++dt) { const float* cp = a.in[I_SC] + ((size_t)(b * 4 + h) * 256 + 16 * dt + 4 * g) * 256 + half * 128 + e0 + fr;
            accC[dt] = (f32x4){cp[0], cp[256], cp[512], cp[768]}; }
    }
    for (int i = tid; i < 2 * 3 * 256; i += 512) { const int mat = i / 768, r = (i % 768) / 256, ch = i & 255;
        const float v = sample ? a.in[I_SCONV][((size_t)b * 3 + r) * 2048 + mat * 1024 + h * 256 + ch] : 0.f;
        *(LAS bf16_t*)(lds + PS + i * 2) = (bf16_t)(pk2(v, 0.f) & 0xffffu); }
    float mstate = sample ? a.in[I_SM][b * 4 + h] : 0.f;
    const float bi = __int_as_float(__builtin_amdgcn_readfirstlane(__float_as_int(a.in[I_BI][h]))), bfg = __int_as_float(__builtin_amdgcn_readfirstlane(__float_as_int(a.in[I_BF][h])));
    __syncthreads();
    const int cmat = tid >> 8, chp2 = (tid & 127) * 2, rh = (tid >> 7) & 1;
    const int eg8 = (tid & 15) * 8, vr0 = 4 * ((tid >> 4) & 15);
    unsigned raw[35];
    {
        const bf16_t* src = (cmat ? MLK : MLQ) + h * 256 + chp2;
#pragma unroll
        for (int r = 0; r < 35; ++r) { int t = 32 * rh - 3 + r; if (t < 0) t = 0; raw[r] = *(const unsigned*)(src + ((size_t)row0 + t) * DM); }
        if (rh == 0) {
#pragma unroll
            for (int r = 0; r < 3; ++r) raw[r] = *(const LAS unsigned*)(lds + PS + (cmat * 768 + r * 256 + chp2) * 2);
        }
    }
    float pxi = 0.f, pxf = 0.f;
    if (wid == 0) { pxi = IFb[((size_t)row0 + lane) * 8 + h]; pxf = IFb[((size_t)row0 + lane) * 8 + 4 + h]; }
    for (int c = 0; c < nch; ++c) {
        const int par = c & 1;
        LAS float* sc = (LAS float*)(lds + SC + par * S_PAR);
        const size_t rbase = (size_t)row0 + (size_t)c * 64;
        if (wid == 0) {
            const float xi = pxi + bi;
            const float xf = pxf + bfg;
            if (c + 1 < nch) { pxi = IFb[(rbase + 64 + lane) * 8 + h]; pxf = IFb[(rbase + 64 + lane) * 8 + 4 + h]; }
            const float lf = fminf(xf, 0.f) - __logf(1.0f + __expf(-fabsf(xf)));
            float bc = lf;
#pragma unroll
            for (int o = 1; o < 64; o <<= 1) { const float t_ = __shfl_up(bc, o); if (lane >= o) bc += t_; }
            const float av = xi - bc;
            float pmx = av;
#pragma unroll
            for (int o = 1; o < 64; o <<= 1) { const float t_ = __shfl_up(pmx, o); if (lane >= o) pmx = fmaxf(pmx, t_); }
            pmx = fmaxf(pmx, mstate);
            const float pm63 = __shfl(pmx, 63), b63 = __shfl(bc, 63);
            sc[S_A / 4 + lane] = av; sc[S_PM / 4 + lane] = pmx; sc[S_WI / 4 + lane] = __expf(mstate - pmx); sc[S_EMT / 4 + lane] = __expf(-(bc + pmx));
            sc[S_WS / 4 + lane] = __expf(av - pm63);
            if (lane == 0) sc[S_DEC / 4] = __expf(mstate - pm63);
            mstate = __int_as_float(__builtin_amdgcn_readfirstlane(__float_as_int(b63 + pm63)));
        }
        const bool conv_out = (c == nch - 1 && half == 0 && rh == 1);
        __syncthreads();
#ifndef NO_CONV
        u32x4 rv[4];
        {
            if (conv_out) {
                float* co = out + (sample ? O_SCONV : O_PCONV) + (size_t)b * 3 * 2048 + cmat * 1024 + h * 256 + chp2;
#pragma unroll
                for (int j = 0; j < 3; ++j) { const unsigned x = raw[32 + j]; co[j * 2048] = bflo(x); co[j * 2048 + 1] = bfhi(x); }
            }
            const LAS float* w = cw + cmat * 1280 + chp2;
            float wl[5], wh[5];
#pragma unroll
            for (int j = 0; j < 5; ++j) { wl[j] = w[j * 256]; wh[j] = w[j * 256 + 1]; }
            const float scl = cmat ? 0.0625f : 1.0f;
            LAS unsigned char* dstS = lds + (cmat ? KS : QS) + (32 * rh) * QROW + chp2 * 2;
            float x0l = bflo(raw[0]), x0h = bfhi(raw[0]), x1l = bflo(raw[1]), x1h = bfhi(raw[1]), x2l = bflo(raw[2]), x2h = bfhi(raw[2]);
#pragma unroll
            for (int t = 0; t < 32; ++t) {
                const float x3l = bflo(raw[t + 3]), x3h = bfhi(raw[t + 3]);
                float ol = __builtin_fmaf(wl[0], x0l, wl[4]), oh = __builtin_fmaf(wh[0], x0h, wh[4]);
                ol = __builtin_fmaf(wl[1], x1l, ol); oh = __builtin_fmaf(wh[1], x1h, oh);
                ol = __builtin_fmaf(wl[2], x2l, ol); oh = __builtin_fmaf(wh[2], x2h, oh);
                ol = __builtin_fmaf(wl[3], x3l, ol); oh = __builtin_fmaf(wh[3], x3h, oh);
                ol = ol * sigmoidf_(ol) * scl; oh = oh * sigmoidf_(oh) * scl;
                *(LAS unsigned*)(dstS + t * QROW) = pk2(ol, oh);
                x0l = x1l; x0h = x1h; x1l = x2l; x1h = x2h; x2l = x3l; x2h = x3h;
            }
        }
        if (tid < 256) {
#pragma unroll
            for (int r = 0; r < 4; ++r) rv[r] = *(const u32x4*)(MLV + (rbase + vr0 + r) * DM + ecol + eg8);
#pragma unroll
            for (int r = 0; r < 4; ++r) {
                const float wsv = sc[S_WS / 4 + vr0 + r]; const u32x4 x = rv[r];
                *(LAS u32x4*)(lds + VS + (vr0 + r) * VROW + eg8 * 2) = x;
                *(LAS u32x4*)(lds + VW + (vr0 + r) * VROW + eg8 * 2) = (u32x4){pk2(bflo(x.x) * wsv, bfhi(x.x) * wsv), pk2(bflo(x.y) * wsv, bfhi(x.y) * wsv),
                                                                              pk2(bflo(x.z) * wsv, bfhi(x.z) * wsv), pk2(bflo(x.w) * wsv, bfhi(x.w) * wsv)};
            }
        }
#endif
        __syncthreads();
        if (c + 1 < nch) {
            const bf16_t* src = (cmat ? MLK : MLQ) + h * 256 + chp2 + (rbase + 64 + 32 * rh - 3) * DM;
#pragma unroll
            for (int r = 0; r < 35; ++r) raw[r] = *(const unsigned*)(src + (size_t)r * DM);
        }
#ifndef NO_S
        {
            const int tt = wid & 3, sh = wid >> 2;
            f32x4 sa[2] = {(f32x4){0.f, 0.f, 0.f, 0.f}, (f32x4){0.f, 0.f, 0.f, 0.f}};
            int qoff = QS + (16 * tt + fr) * QROW + 16 * g, koff = KS + (32 * sh + fr) * QROW + 16 * g;
            asm volatile("" : "+v"(qoff), "+v"(koff));
            bf16x8 sq[2][2], sk[2][2][2];
#define LD_S(bi, kp) do { _Pragma("unroll") for (int k2 = 0; k2 < 2; ++k2) { sq[bi][k2] = *(const LAS bf16x8*)(lds + qoff + 64 * (2 * (kp) + k2)); \
                _Pragma("unroll") for (int st2 = 0; st2 < 2; ++st2) sk[bi][k2][st2] = *(const LAS bf16x8*)(lds + koff + st2 * 16 * QROW + 64 * (2 * (kp) + k2)); } } while (0)
            LD_S(0, 0);
#pragma unroll
            for (int kp = 0; kp < 4; ++kp) {
                if (kp < 3) LD_S((kp + 1) & 1, kp + 1);
                __builtin_amdgcn_sched_barrier(0);
#pragma unroll
                for (int k2 = 0; k2 < 2; ++k2)
#pragma unroll
                    for (int st2 = 0; st2 < 2; ++st2) sa[st2] = __builtin_amdgcn_mfma_f32_16x16x32_bf16(sk[kp & 1][k2][st2], sq[kp & 1][k2], sa[st2], 0, 0, 0);
                __builtin_amdgcn_sched_barrier(0);
            }
#undef LD_S
            const int t = 16 * tt + fr; const float pmt = sc[S_PM / 4 + t]; float rs = 0.f;
#pragma unroll
            for (int st2 = 0; st2 < 2; ++st2) {
                const int s0 = 16 * (2 * sh + st2) + 4 * g;
                const f32x4 av = *(const LAS f32x4*)(sc + S_A / 4 + s0);
                float p[4];
#pragma unroll
                for (int jj = 0; jj < 4; ++jj) { p[jj] = (s0 + jj <= t) ? sa[st2][jj] * __expf(av[jj] - pmt) : 0.f; rs += p[jj]; }
                *(LAS u32x2*)(lds + PS + t * PROW + s0 * 2) = (u32x2){pk2(p[0], p[1]), pk2(p[2], p[3])};
            }
            rs += __shfl_xor(rs, 16); rs += __shfl_xor(rs, 32);
            if (g == 0) sc[(sh ? S_RS1 : S_RS0) / 4 + t] = rs;
            int tidS = tid; asm volatile("" : "+v"(tidS)); const int tq = tidS >> 3, part = tidS & 7; float d = 0.f;
#pragma unroll
            for (int i = 0; i < 4; ++i) {
                const u32x4 x = *(const LAS u32x4*)(lds + QS + tq * QROW + (32 * part + 8 * i) * 2);
                const f32x4 n0 = *(const LAS f32x4*)(nv + 32 * part + 8 * i), n1 = *(const LAS f32x4*)(nv + 32 * part + 8 * i + 4);
                d += bflo(x.x) * n0[0] + bfhi(x.x) * n0[1] + bflo(x.y) * n0[2] + bfhi(x.y) * n0[3] + bflo(x.z) * n1[0] + bfhi(x.z) * n1[1] + bflo(x.w) * n1[2] + bfhi(x.w) * n1[3];
            }
            d += __shfl_xor(d, 1); d += __shfl_xor(d, 2); d += __shfl_xor(d, 4);
            if (part == 0) sc[S_QN / 4 + tq] = d;
        }
#endif
        __syncthreads();
#ifndef NO_H
        {
            f32x4 ao[4] = {(f32x4){0.f, 0.f, 0.f, 0.f}, (f32x4){0.f, 0.f, 0.f, 0.f}, (f32x4){0.f, 0.f, 0.f, 0.f}, (f32x4){0.f, 0.f, 0.f, 0.f}};
            int qa = QS + fr * QROW + 8 * g;
            asm volatile("" : "+v"(qa));
            u32x2 xq[2][2][4][2];
#define LD_Q(bi, kp) do { _Pragma("unroll") for (int k2 = 0; k2 < 2; ++k2) _Pragma("unroll") for (int tt = 0; tt < 4; ++tt) { \
                xq[bi][k2][tt][0] = *(const LAS u32x2*)(lds + qa + tt * 16 * QROW + 64 * (2 * (kp) + k2)); xq[bi][k2][tt][1] = *(const LAS u32x2*)(lds + qa + tt * 16 * QROW + 64 * (2 * (kp) + k2) + 32); } } while (0)
            LD_Q(0, 0);
#pragma unroll
            for (int kp = 0; kp < 4; ++kp) {
                if (kp < 3) LD_Q((kp + 1) & 1, kp + 1);
                __builtin_amdgcn_sched_barrier(0);
#pragma unroll
                for (int k2 = 0; k2 < 2; ++k2) {
                    const int kk = 2 * kp + k2;
                    const f32x4 c0 = accC[2 * kk], c1 = accC[2 * kk + 1];
                    const u32x4 bw = (u32x4){pk2(c0[0], c0[1]), pk2(c0[2], c0[3]), pk2(c1[0], c1[1]), pk2(c1[2], c1[3])};
                    const bf16x8 bfr = __builtin_bit_cast(bf16x8, bw);
#pragma unroll
                    for (int tt = 0; tt < 4; ++tt) {
                        const u32x2 x0 = xq[kp & 1][k2][tt][0], x1 = xq[kp & 1][k2][tt][1];
                        const bf16x8 afr = __builtin_bit_cast(bf16x8, (u32x4){x0.x, x0.y, x1.x, x1.y});
                        ao[tt] = __builtin_amdgcn_mfma_f32_16x16x32_bf16(afr, bfr, ao[tt], 0, 0, 0);
                    }
                }
                __builtin_amdgcn_sched_barrier(0);
            }
#undef LD_Q
#pragma unroll
            for (int tt = 0; tt < 4; ++tt) { const f32x4 wi = *(const LAS f32x4*)(sc + S_WI / 4 + 16 * tt + 4 * g); ao[tt] = ao[tt] * wi; }
            const int q = (lane & 15) >> 2, p = lane & 3;
            int va = VS + (8 * g + q) * VROW + (e0 + 4 * p) * 2, pa = PS + fr * PROW + 16 * g;
            asm volatile("" : "+v"(va), "+v"(pa));
#pragma unroll
            for (int ks = 0; ks < 2; ++ks) {
                const s16x4 v0 = tr_read(lds + va + ks * 32 * VROW);
                const s16x4 v1 = tr_read(lds + va + ks * 32 * VROW + 4 * VROW);
                const bf16x8 bfr = (bf16x8){v0[0], v0[1], v0[2], v0[3], v1[0], v1[1], v1[2], v1[3]};
#pragma unroll
                for (int tt = 0; tt < 4; ++tt) {
                    const bf16x8 afr = *(const LAS bf16x8*)(lds + pa + tt * 16 * PROW + 64 * ks);
                    ao[tt] = __builtin_amdgcn_mfma_f32_16x16x32_bf16(afr, bfr, ao[tt], 0, 0, 0);
                }
            }
            int hoff = 4 * g * DM + ecol + e0 + fr;
            int sco = (par * S_PAR) + 16 * g;
            asm volatile("" : "+v"(hoff), "+v"(sco));
            bf16_t* hp = (bf16_t*)(ws + WS_B0 + 2 * SZ1) + rbase * DM + hoff;
#pragma unroll
            for (int tt = 0; tt < 4; ++tt) {
                const LAS unsigned char* sb = lds + SC + sco + 64 * tt;
                const f32x4 wi = *(const LAS f32x4*)(sb + S_WI), qn = *(const LAS f32x4*)(sb + S_QN), r0 = *(const LAS f32x4*)(sb + S_RS0),
                            r1 = *(const LAS f32x4*)(sb + S_RS1), em = *(const LAS f32x4*)(sb + S_EMT);
#pragma unroll
                for (int jj = 0; jj < 4; ++jj) {
                    const float den = wi[jj] * qn[jj] + r0[jj] + r1[jj];
                    const float hv = ao[tt][jj] * rcpf_(fmaxf(fabsf(den), em[jj]));
                    hp[(size_t)(16 * tt + jj) * DM] = (bf16_t)(pk2(hv, 0.f) & 0xffffu);
                }
                __builtin_amdgcn_sched_barrier(0);
            }
        }
#endif
#ifndef NO_CU
        {
            const float dec = sc[S_DEC / 4];
            const int q = (lane & 15) >> 2, p = lane & 3;
            int vwa = VW + (8 * g + q) * VROW + (e0 + 4 * p) * 2, ka = KS + (8 * g + q) * QROW + 8 * p;
            asm volatile("" : "+v"(vwa), "+v"(ka));
            bf16x8 bw[2];
#pragma unroll
            for (int ks = 0; ks < 2; ++ks) {
                const s16x4 v0 = tr_read(lds + vwa + ks * 32 * VROW);
                const s16x4 v1 = tr_read(lds + vwa + ks * 32 * VROW + 4 * VROW);
                bw[ks] = (bf16x8){v0[0], v0[1], v0[2], v0[3], v1[0], v1[1], v1[2], v1[3]};
            }
            s16x4 kr[2][2][2][2];
#define LD_K(bi, gp) do { _Pragma("unroll") for (int d4 = 0; d4 < 2; ++d4) _Pragma("unroll") for (int ks = 0; ks < 2; ++ks) { \
                kr[bi][d4][ks][0] = tr_read(lds + ka + ks * 32 * QROW + (2 * (gp) + d4) * 32); kr[bi][d4][ks][1] = tr_read(lds + ka + ks * 32 * QROW + (2 * (gp) + d4) * 32 + 4 * QROW); } } while (0)
            LD_K(0, 0);
#pragma unroll
            for (int gp = 0; gp < 8; ++gp) {
                if (gp < 7) LD_K((gp + 1) & 1, gp + 1);
                __builtin_amdgcn_sched_barrier(0);
#pragma unroll
                for (int d4 = 0; d4 < 2; ++d4) {
                    const int dt = 2 * gp + d4;
                    accC[dt] = accC[dt] * dec;
#pragma unroll
                    for (int ks = 0; ks < 2; ++ks) {
                        const s16x4 k0 = kr[gp & 1][d4][ks][0], k1 = kr[gp & 1][d4][ks][1];
                        const bf16x8 afr = (bf16x8){k0[0], k0[1], k0[2], k0[3], k1[0], k1[1], k1[2], k1[3]};
                        accC[dt] = __builtin_amdgcn_mfma_f32_16x16x32_bf16(afr, bw[ks], accC[dt], 0, 0, 0);
                    }
                }
                __builtin_amdgcn_sched_barrier(0);
            }
#undef LD_K
            int tidN = tid; asm volatile("" : "+v"(tidN)); const int dn = tidN >> 1, sh2 = tidN & 1; float sn = 0.f;
#pragma unroll 8
            for (int s = 0; s < 32; ++s) { const int ss = 32 * sh2 + s; sn += sc[S_WS / 4 + ss] * bf1(*(const LAS bf16_t*)(lds + KS + ss * QROW + dn * 2)); }
            sn += __shfl_xor(sn, 1);
            if (sh2 == 0) nv[dn] = dec * nv[dn] + sn;
        }
#endif
    }
    __syncthreads();
    {
        float* Co = out + (sample ? O_SC : O_PC) + (size_t)(b * 4 + h) * 65536;
#pragma unroll
        for (int dt = 0; dt < 16; ++dt)
#pragma unroll
            for (int jj = 0; jj < 4; ++jj) Co[(size_t)(16 * dt + 4 * g + jj) * 256 + half * 128 + e0 + fr] = accC[dt][jj];
        if (half == 0) {
            if (tid < 256) out[(sample ? O_SN : O_PN) + (size_t)(b * 4 + h) * 256 + tid] = nv[tid];
            if (tid == 0) out[(sample ? O_SM : O_PM) + b * 4 + h] = mstate;
        }
    }
    __syncthreads();
}
}

namespace at {
constexpr int KB = 0, VB = 18432, TB = 55296, KROW = 144, VROWA = 288, VBUF = 64 * VROWA;
__device__ __forceinline__ void attn_unit(const Args& a, LAS unsigned char* lds, bool sample, int b, int h, int c0, int nch) {
    const int tid = threadIdx.x, lane = tid & 63, wid = __builtin_amdgcn_readfirstlane(tid >> 6), fr = lane & 15, g = lane >> 4;
    unsigned char* ws = a.ws;
    const bf16_t* AQ = (const bf16_t*)(ws + WS_B0 + 4 * SZ1); const bf16_t* AK = (const bf16_t*)(a.out + O_Y); const bf16_t* AV = AK + (size_t)TT * DM; bf16_t* AO = (bf16_t*)(ws + WS_B0 + 4 * SZ1);
    const bf16_t* CK = (const bf16_t*)(ws + WS_CK); const bf16_t* CV = (const bf16_t*)(ws + WS_CV);
    const int cw = c0 + (wid >> 1), qh = wid & 1; const bool active = (wid >> 1) < nch;
    const size_t qrow0 = sample ? (size_t)TP + b * DSEQ + 32 * qh : (size_t)b * SEQ + (size_t)cw * 64 + 32 * qh;
    LAS float* tbl = (LAS float*)(lds + TB);
    if (tid < 320) tbl[tid] = a.in[I_RELB][h * 257 + (tid < 256 ? tid : 256)] * 1.4426950408889634f;
    bf16x8 qf[2][2];
    if (active) {
#pragma unroll
        for (int tt = 0; tt < 2; ++tt)
#pragma unroll
            for (int ks = 0; ks < 2; ++ks) qf[tt][ks] = *(const bf16x8*)(AQ + (qrow0 + 16 * tt + fr) * DM + h * 64 + 32 * ks + 8 * g);
    }
    const int jlo = sample ? 0 : (c0 - 8 > 0 ? c0 - 8 : 0), jhi = sample ? 8 : c0 + nch - 1;
    const int lrow = tid >> 3, lch = (tid & 7) * 8;
    auto kv_src = [&](int j, const bf16_t*& kp, const bf16_t*& vp) {
        if (sample) { if (j < 8) { const size_t o = ((size_t)b * NPAST + j * 64 + lrow) * DM + h * 64 + lch; kp = CK + o; vp = CV + o; }
                      else { const size_t o = ((size_t)TP + b * DSEQ + lrow) * DM + h * 64 + lch; kp = AK + o; vp = AV + o; } }
        else { const size_t o = ((size_t)b * SEQ + (size_t)j * 64 + lrow) * DM + h * 64 + lch; kp = AK + o; vp = AV + o; }
    };
    u32x4 kreg, vreg;
    { const bf16_t *kp, *vp; kv_src(jlo, kp, vp); kreg = *(const u32x4*)kp; vreg = *(const u32x4*)vp; }
    *(LAS u32x4*)(lds + KB + lrow * KROW + lch * 2) = kreg; *(LAS u32x4*)(lds + VB + lrow * VROWA + lch * 2) = vreg;
    f32x4 o[4][2];
#pragma unroll
    for (int et = 0; et < 4; ++et) { o[et][0] = (f32x4){0.f, 0.f, 0.f, 0.f}; o[et][1] = (f32x4){0.f, 0.f, 0.f, 0.f}; }
    float mrun[2] = {-INFINITY, -INFINITY}, lsum[2] = {0.f, 0.f};
    __syncthreads();
    for (int j = jlo; j <= jhi; ++j) {
        const int buf = (j - jlo) & 1;
        if (j < jhi) { const bf16_t *kp, *vp; kv_src(j + 1, kp, vp); kreg = *(const u32x4*)kp; vreg = *(const u32x4*)vp; }
        const int dq = (sample ? 8 : cw) - j;
        if (active && dq >= 0 && dq <= 8) {
            const LAS unsigned char* kb = lds + KB + buf * 9216; const LAS unsigned char* vb = lds + VB + buf * VBUF;
            f32x4 s[4][2];
#pragma unroll
            for (int st = 0; st < 4; ++st) { s[st][0] = (f32x4){0.f, 0.f, 0.f, 0.f}; s[st][1] = (f32x4){0.f, 0.f, 0.f, 0.f}; }
#pragma unroll
            for (int ks = 0; ks < 2; ++ks)
#pragma unroll
                for (int st = 0; st < 4; ++st) {
                    const bf16x8 kf = *(const LAS bf16x8*)(kb + (16 * st + fr) * KROW + (32 * ks + 8 * g) * 2);
                    s[st][0] = __builtin_amdgcn_mfma_f32_16x16x32_bf16(kf, qf[0][ks], s[st][0], 0, 0, 0);
                    s[st][1] = __builtin_amdgcn_mfma_f32_16x16x32_bf16(kf, qf[1][ks], s[st][1], 0, 0, 0);
                }
            const float bfar = tbl[256];
            constexpr float SC2 = 0.125f * 1.4426950408889634f;
            if (dq < 3) {
                const int relb = 64 * dq + 32 * qh + fr - 4 * g + 128;
#pragma unroll
                for (int tt = 0; tt < 2; ++tt)
#pragma unroll
                    for (int st = 0; st < 4; ++st)
#pragma unroll
                        for (int jj = 0; jj < 4; ++jj) s[st][tt][jj] = __builtin_fmaf(s[st][tt][jj], SC2, tbl[relb + 16 * tt - 16 * st - jj]);
            } else {
#pragma unroll
                for (int tt = 0; tt < 2; ++tt)
#pragma unroll
                    for (int st = 0; st < 4; ++st) s[st][tt] = s[st][tt] * SC2 + bfar;
            }
#pragma unroll
            for (int tt = 0; tt < 2; ++tt) {
                float mx = fmaxf(fmaxf(s[0][tt][0], s[0][tt][1]), fmaxf(s[0][tt][2], s[0][tt][3]));
#pragma unroll
                for (int st = 1; st < 4; ++st) mx = fmaxf(fmaxf(mx, s[st][tt][0]), fmaxf(fmaxf(s[st][tt][1], s[st][tt][2]), s[st][tt][3]));
                mx = fmaxf(mx, __shfl_xor(mx, 16)); mx = fmaxf(mx, __shfl_xor(mx, 32));
                const float mnew = fmaxf(mrun[tt], mx), alpha = __builtin_amdgcn_exp2f(mrun[tt] - mnew);
                const bool chg = mnew > mrun[tt]; mrun[tt] = mnew;
                f32x4 psv = (f32x4){0.f, 0.f, 0.f, 0.f}; const float nmn = -mnew; const f32x4 nm4 = (f32x4){nmn, nmn, nmn, nmn};
#pragma unroll
                for (int st = 0; st < 4; ++st) {
                    const f32x4 d = s[st][tt] + nm4;
                    const f32x4 pv4 = (f32x4){__builtin_amdgcn_exp2f(d[0]), __builtin_amdgcn_exp2f(d[1]), __builtin_amdgcn_exp2f(d[2]), __builtin_amdgcn_exp2f(d[3])};
                    s[st][tt] = pv4; psv = psv + pv4;
                }
                lsum[tt] = lsum[tt] * alpha + ((psv[0] + psv[1]) + (psv[2] + psv[3]));
                if (__any(chg)) {
#pragma unroll
                    for (int et = 0; et < 4; ++et) o[et][tt] = o[et][tt] * alpha;
                }
            }
            const int q = (lane & 15) >> 2, p = lane & 3;
#pragma unroll
            for (int ks2 = 0; ks2 < 2; ++ks2) {
                bf16x8 pf[2];
#pragma unroll
                for (int tt = 0; tt < 2; ++tt) { const f32x4 p0 = s[2 * ks2][tt], p1 = s[2 * ks2 + 1][tt];
                    pf[tt] = __builtin_bit_cast(bf16x8, (u32x4){pk2(p0[0], p0[1]), pk2(p0[2], p0[3]), pk2(p1[0], p1[1]), pk2(p1[2], p1[3])}); }
#pragma unroll
                for (int et = 0; et < 4; ++et) {
                    const s16x4 v0 = tr_read(vb + (32 * ks2 + 4 * g + q) * VROWA + (16 * et + 4 * p) * 2);
                    const s16x4 v1 = tr_read(vb + (32 * ks2 + 16 + 4 * g + q) * VROWA + (16 * et + 4 * p) * 2);
                    const bf16x8 vf = (bf16x8){v0[0], v0[1], v0[2], v0[3], v1[0], v1[1], v1[2], v1[3]};
                    o[et][0] = __builtin_amdgcn_mfma_f32_16x16x32_bf16(vf, pf[0], o[et][0], 0, 0, 0);
                    o[et][1] = __builtin_amdgcn_mfma_f32_16x16x32_bf16(vf, pf[1], o[et][1], 0, 0, 0);
                }
            }
        }
        if (j < jhi) { *(LAS u32x4*)(lds + KB + (buf ^ 1) * 9216 + lrow * KROW + lch * 2) = kreg; *(LAS u32x4*)(lds + VB + (buf ^ 1) * VBUF + lrow * VROWA + lch * 2) = vreg; }
        __syncthreads();
    }
    if (active) {
#pragma unroll
        for (int tt = 0; tt < 2; ++tt) {
            float l = lsum[tt]; l += __shfl_xor(l, 16); l += __shfl_xor(l, 32);
            const float inv = 1.f / l;
#pragma unroll
            for (int et = 0; et < 4; ++et) {
                const f32x4 v = o[et][tt] * inv;
                *(u32x2*)(AO + (qrow0 + 16 * tt + fr) * DM + h * 64 + 16 * et + 4 * g) = (u32x2){pk2(v[0], v[1]), pk2(v[2], v[3])};
            }
        }
    }
}
}

constexpr int NPHASE = 14;
__global__ void __launch_bounds__(512, 2) mega_fwd(Args args) {
    extern __shared__ __attribute__((aligned(16))) unsigned char lds_raw[];
    LAS unsigned char* lds = (LAS unsigned char*)lds_raw;
    unsigned char* ws = args.ws;
    float* U = args.out + O_Y;
    bf16_t* HB = (bf16_t*)(ws + WS_HB);
    bf16_t* UB = (bf16_t*)(ws + WS_B0 + 3 * SZ1);
    bf16_t* ACT = (bf16_t*)(ws + WS_ACT);
    const int lo = args.ph_lo, hi = args.ph_hi;
    const int G = gridDim.x, blk = blockIdx.x;
#ifndef PH_MASK
#define PH_MASK 0xFFFF
#endif
#define IN(k) (((PH_MASK >> (k)) & 1) && lo <= (k) && (k) < hi)
#ifndef DUP_MASK
#define DUP_MASK 0
#endif
#define REP(k) for (int rep_ = 0; rep_ < 1 + ((DUP_MASK >> (k)) & 1); ++rep_)
    volatile LAS unsigned* bst = (volatile LAS unsigned*)(lds + LDS_BYTES - 64);
    if (threadIdx.x < 2) bst[threadIdx.x] = 0u;
    __syncthreads();
    if (hi - lo > 1) (void)xcd_barrier_post((unsigned*)(ws + WS_BAR), bst);
#define SEAM(k) do { if (IN(k) && IN((k) + 1)) { if ((k) == 0) cg::this_grid().sync(); else xcd_barrier((unsigned*)(args.ws + WS_BAR), (volatile LAS unsigned*)(lds + LDS_BYTES - 64)); } } while (0)

    if (IN(0)) { p0_prologue(args, lds); if (DUP_MASK & 1) { __syncthreads(); p0_prologue(args, lds); } }
    SEAM(0);
    if (IN(1)) {
        pg8::Gemm g{}; g.A[0] = HB; g.Bt[0] = (const bf16_t*)(ws + WS_WGU1); g.M = TT; g.N = 2 * FF; g.K = DM;
        pg8::StaticOrder S; S.init(TT, 2 * FF, G, blk, 1);
        pg8::EpiSwiglu E{ACT};
        pg8::gemm_phase(lds, g, S, E);
        if ((DUP_MASK >> 1) & 1) pg8::gemm_phase(lds, g, S, E);
    }
    SEAM(1);
    if (IN(2)) {
        pg8::Gemm g{}; g.A[0] = ACT; g.Bt[0] = (const bf16_t*)(ws + WS_WD1); g.M = TT; g.N = DM; g.K = FF;
        pg8::StaticOrder S; S.init(TP, DM, G, blk, 1);
        pg8::EpiResid E{UB, nullptr, nullptr, HB, 0.5f, 1};
        pg8::gemm_phase(lds, g, S, E);
    }
    SEAM(2);
    if (IN(3)) {
        if (blk < 16) {
            pg8::Gemm g{}; g.A[0] = ACT; g.Bt[0] = (const bf16_t*)(ws + WS_WD1); g.M = TT; g.N = DM; g.K = FF;
            pg8::StaticOrder S; S.init(TS, DM, G, blk, 1, TP / 256);
            pg8::EpiResid E{UB, nullptr, nullptr, HB, 0.5f, 1};
            pg8::gemm_phase(lds, g, S, E);
        } else {
            ln_pass<1>(UB, nullptr, HB, args.in[I_LN1G], args.in[I_LN1B], (const float*)(ws + WS_WIF), (float*)(ws + WS_IF), 0, TP, 16, G - 16);
            const size_t gt2 = (size_t)(blk - 16) * 512 + threadIdx.x, NT2 = (size_t)(G - 16) * 512;
            cvt_f32_bf16(args.in[I_CK], (bf16_t*)(ws + WS_CK), (size_t)NSB * NPAST * DM / 8, gt2, NT2);
            cvt_f32_bf16(args.in[I_CV], (bf16_t*)(ws + WS_CV), (size_t)NSB * NPAST * DM / 8, gt2, NT2);
        }
        xcd_barrier((unsigned*)(args.ws + WS_BAR), (volatile LAS unsigned*)(lds + LDS_BYTES - 64));
        ln_pass<1>(UB, nullptr, HB, args.in[I_LN1G], args.in[I_LN1B], (const float*)(ws + WS_WIF), (float*)(ws + WS_IF), TP, TT, 0, G);
    }
    SEAM(3);
    if (IN(4)) {
        pg8::Gemm g{}; g.A[0] = HB; g.Bt[0] = (const bf16_t*)(ws + WS_WML); g.M = TT; g.N = 7168; g.K = DM;
        pg8::StaticOrder S; S.init(TT, 7168, G, blk, 1);
        pg8::EpiSplitBf16 E{}; for (int i = 0; i < 5; ++i) E.dst[i] = (bf16_t*)(ws + WS_B0 + i * SZ1); E.dst[5] = (bf16_t*)U; E.dst[6] = (bf16_t*)U + (size_t)TT * DM;
        E.pk = args.out + O_PK; E.sk = args.out + O_SK; E.pv = args.out + O_PV; E.sv = args.out + O_SV; E.kt = 5; E.vt = 6;
        pg8::gemm_phase(lds, g, S, E);
    }
    SEAM(4);
    if (IN(5)) {
        for (int it = blk; it < 384; it += G) {
            int item = it;
            if (G == 256) {
                if (it < 256) { const int x = it & 7, j = it >> 3; item = ((x * 16 + (j >> 1)) << 1) | (j & 1); }
                else { const int sidx = it - 256, x = sidx & 7, j = sidx >> 3; item = 256 + (((x * 8 + (j >> 1)) << 1) | (j & 1)); }
            }
            ml::mlstm_item(args, lds, item);
        }
    }
    SEAM(5);
    if (IN(6)) {
        headln_pass((bf16_t*)(ws + WS_B0 + 2 * SZ1), (const bf16_t*)(ws + WS_B0 + 3 * SZ1), args.in[I_MLNG]);
    }
    if (IN(7)) {
        for (int u = blk; u < 4096 + 256; u += G) {
            if (u < 4096) { const int i = u >> 8, bb = u & 255, quad = i & 7, bh = (i >> 3) * 256 + bb; at::attn_unit(args, lds, false, bh >> 4, bh & 15, quad * 4, 4); }
            else { const int s = u - 4096; at::attn_unit(args, lds, true, s >> 4, s & 15, 8, 1); }
        }
    }
    SEAM(7);
    if (IN(8)) {
        pg8::Gemm g{}; g.A[0] = HB; g.A[1] = (const bf16_t*)(ws + WS_B0 + 2 * SZ1); g.A[2] = HB; g.A[3] = (const bf16_t*)(ws + WS_B0 + 4 * SZ1);
        g.Bt[0] = (const bf16_t*)(ws + WS_WGM); g.Bt[1] = (const bf16_t*)(ws + WS_WMLP); g.Bt[2] = (const bf16_t*)(ws + WS_WGA); g.Bt[3] = (const bf16_t*)(ws + WS_WATTP);
        g.M = TT; g.N = DM; g.K = DM;
        pg8::StaticOrder S; S.init(TP, DM, G, blk, 4);
        pg8::EpiMerge E{(bf16_t*)(ws + WS_B0), (u32x4*)(ws + WS_GSCR) + (size_t)blk * 48 * 512};
        pg8::gemm_phase(lds, g, S, E);
    }
    SEAM(8);
    if (IN(9)) {
        if (blk < 16) {
            pg8::Gemm g{}; g.A[0] = HB; g.A[1] = (const bf16_t*)(ws + WS_B0 + 2 * SZ1); g.A[2] = HB; g.A[3] = (const bf16_t*)(ws + WS_B0 + 4 * SZ1);
            g.Bt[0] = (const bf16_t*)(ws + WS_WGM); g.Bt[1] = (const bf16_t*)(ws + WS_WMLP); g.Bt[2] = (const bf16_t*)(ws + WS_WGA); g.Bt[3] = (const bf16_t*)(ws + WS_WATTP);
            g.M = TT; g.N = DM; g.K = DM;
            pg8::StaticOrder S; S.init(TS, DM, G, blk, 4, TP / 256);
            pg8::EpiMerge E{(bf16_t*)(ws + WS_B0), (u32x4*)(ws + WS_GSCR) + (size_t)blk * 48 * 512};
            pg8::gemm_phase(lds, g, S, E);
        } else {
            pg8::Gemm g{}; g.A[0] = (const bf16_t*)(ws + WS_B0); g.Bt[0] = (const bf16_t*)(ws + WS_WOUT); g.M = TT; g.N = DM; g.K = DM;
            pg8::StaticOrder S; S.init(TP, DM, G - 16, blk - 16, 1);
            pg8::EpiResid E{UB, nullptr, nullptr, HB, 1.0f, 1};
            pg8::gemm_phase(lds, g, S, E);
        }
    }
    SEAM(9);
    if (IN(10)) {
        if (blk < 16) {
            pg8::Gemm g{}; g.A[0] = (const bf16_t*)(ws + WS_B0); g.Bt[0] = (const bf16_t*)(ws + WS_WOUT); g.M = TT; g.N = DM; g.K = DM;
            pg8::StaticOrder S; S.init(TS, DM, G, blk, 1, TP / 256);
            pg8::EpiResid E{UB, nullptr, nullptr, HB, 1.0f, 1};
            pg8::gemm_phase(lds, g, S, E);
        } else {
            ln_pass<2>(UB, nullptr, HB, args.in[I_LN2G], args.in[I_LN2B], nullptr, nullptr, 0, TP, 16, G - 16);
        }
        xcd_barrier((unsigned*)(args.ws + WS_BAR), (volatile LAS unsigned*)(lds + LDS_BYTES - 64));
        ln_pass<2>(UB, nullptr, HB, args.in[I_LN2G], args.in[I_LN2B], nullptr, nullptr, TP, TT, 0, G);
    }
    SEAM(10);
    if (IN(11)) {
        pg8::Gemm g{}; g.A[0] = HB; g.Bt[0] = (const bf16_t*)(ws + WS_WGU2); g.M = TT; g.N = 2 * FF; g.K = DM;
        pg8::StaticOrder S; S.init(TT, 2 * FF, G, blk, 1);
        pg8::EpiSwiglu E{ACT};
        pg8::gemm_phase(lds, g, S, E);
        if ((DUP_MASK >> 11) & 1) pg8::gemm_phase(lds, g, S, E);
    }
    SEAM(11);
    if (IN(12)) {
        pg8::Gemm g{}; g.A[0] = ACT; g.Bt[0] = (const bf16_t*)(ws + WS_WD2); g.M = TT; g.N = DM; g.K = FF;
        pg8::StaticOrder S; S.init(TP, DM, G, blk, 1);
        pg8::EpiResid E{UB, nullptr, nullptr, HB, 0.5f, 1};
        pg8::gemm_phase(lds, g, S, E);
    }
    SEAM(12);
    if (IN(13)) {
        if (blk < 16) {
            pg8::Gemm g{}; g.A[0] = ACT; g.Bt[0] = (const bf16_t*)(ws + WS_WD2); g.M = TT; g.N = DM; g.K = FF;
            pg8::StaticOrder S; S.init(TS, DM, G, blk, 1, TP / 256);
            pg8::EpiResid E{UB, nullptr, nullptr, HB, 0.5f, 1};
            pg8::gemm_phase(lds, g, S, E);
        } else {
            ln_pass<3>(UB, U, nullptr, args.in[I_LN3G], args.in[I_LN3B], nullptr, nullptr, 0, TP, 16, G - 16);
        }
        xcd_barrier((unsigned*)(args.ws + WS_BAR), (volatile LAS unsigned*)(lds + LDS_BYTES - 64));
        ln_pass<3>(UB, U, nullptr, args.in[I_LN3G], args.in[I_LN3B], nullptr, nullptr, TP, TT, 0, G);
    }
#undef IN
#undef SEAM
}

extern "C" void kernel_launch(void* const* d_in, const int* in_sizes, int n_in, void* d_out, int out_size, void* d_ws, size_t ws_size, hipStream_t stream) {
    static int grid = 0;
    if (grid == 0) {
        if (n_in != 28 || ws_size < WS_END || (size_t)out_size != O_END) {
            fprintf(stderr, "kernel_launch: unexpected sizes n_in %d ws %zu (need %zu) out %d (expect %zu)\n", n_in, ws_size, (size_t)WS_END, out_size, (size_t)O_END);
            if (n_in != 28 || ws_size < WS_END) { grid = -1; return; }
        }
        (void)hipFuncSetAttribute((const void*)mega_fwd, hipFuncAttributeMaxDynamicSharedMemorySize, LDS_BYTES);
        int dev = 0, cus = 0, per_cu = 0;
        (void)hipGetDevice(&dev); (void)hipDeviceGetAttribute(&cus, hipDeviceAttributeMultiprocessorCount, dev);
        (void)hipOccupancyMaxActiveBlocksPerMultiprocessor(&per_cu, (const void*)mega_fwd, 512, LDS_BYTES);
        if (per_cu < 1) fprintf(stderr, "kernel_launch: occupancy query says %d blocks/CU\n", per_cu);
        (void)hipGetLastError();
        grid = cus > 0 ? cus : 256;
    }
    if (grid < 0) return;
    Args a{};
    for (int i = 0; i < 28; ++i) a.in[i] = (const float*)d_in[i];
    a.out = (float*)d_out; a.ws = (unsigned char*)d_ws;
#if MK_ONE_LAUNCH
    (void)hipMemsetAsync((char*)d_ws + WS_BAR, 0, 16384, stream);
    a.ph_lo = 0; a.ph_hi = NPHASE;
    void* kargs[] = {&a};
    hipError_t e = hipLaunchCooperativeKernel((const void*)mega_fwd, dim3(grid), dim3(512), kargs, LDS_BYTES, stream);
    if (e != hipSuccess) fprintf(stderr, "cooperative launch failed: %s (grid %d)\n", hipGetErrorString(e), grid);
#else
    for (int p = 0; p < NPHASE; ++p) { a.ph_lo = p; a.ph_hi = p + 1; hipLaunchKernelGGL(mega_fwd, dim3(grid), dim3(512), LDS_BYTES, stream, a); }
#endif
}
```

```cpp
#include <hip/hip_runtime.h>
#include <hip/hip_cooperative_groups.h>
#include <cstdio>
#include <cstdint>
namespace cg = cooperative_groups;

#ifndef MK_ONE_LAUNCH
#define MK_ONE_LAUNCH 1
#endif

#define LAS __attribute__((address_space(3)))
typedef unsigned short bf16_t;
typedef short bf16x8 __attribute__((ext_vector_type(8)));
typedef short s16x4 __attribute__((ext_vector_type(4)));
typedef float f32x4 __attribute__((ext_vector_type(4)));
typedef unsigned u32x4 __attribute__((ext_vector_type(4)));
typedef unsigned u32x2 __attribute__((ext_vector_type(2)));

constexpr int DM = 1024, TP = 65536, TS = 1024, TT = TP + TS, FF = 2816, SEQ = 2048, NB = 32, NSB = 16, DSEQ = 64, NPAST = 512;
constexpr int INW = 9224;
constexpr float ALPHA = 1.189207115002721f;
constexpr float LN_EPS = 1e-5f;
constexpr size_t MiB = 1u << 20;
constexpr size_t SZ1 = (size_t)TT * DM * 2;
constexpr size_t WS_WGU1 = 0, WS_WD1 = 11 * MiB, WS_WGU2 = 17 * MiB, WS_WD2 = 28 * MiB, WS_WML = 34 * MiB, WS_WATT = 42 * MiB,
                 WS_WGM = 48 * MiB, WS_WGA = 50 * MiB, WS_WMLP = 52 * MiB, WS_WATTP = 54 * MiB, WS_WOUT = 56 * MiB, WS_WIF = 58 * MiB, WS_IF = 59 * MiB, WS_BAR = 63 * MiB;
constexpr size_t WS_HB = 64 * MiB;
constexpr size_t WS_ACT = 194 * MiB;
constexpr size_t WS_B0 = 194 * MiB;
constexpr size_t WS_CK = WS_B0 + 5 * SZ1, WS_CV = WS_CK + 16 * MiB, WS_GSCR = WS_CV + 16 * MiB, WS_END = WS_GSCR + 96 * MiB;
static_assert(WS_END <= 1024 * MiB, "ws map");
constexpr size_t O_Y = 0, O_PCONV = (size_t)TT * DM, O_SCONV = O_PCONV + 32 * 3 * 2048, O_PC = O_SCONV + 16 * 3 * 2048, O_SC = O_PC + (size_t)32 * 4 * 65536,
                 O_PN = O_SC + (size_t)16 * 4 * 65536, O_SN = O_PN + 32 * 4 * 256, O_PM = O_SN + 16 * 4 * 256, O_SM = O_PM + 128, O_PK = O_SM + 64,
                 O_SK = O_PK + (size_t)32 * 512 * 1024, O_PV = O_SK + (size_t)16 * 64 * 1024, O_SV = O_PV + (size_t)32 * 512 * 1024, O_END = O_SV + (size_t)16 * 64 * 1024;

constexpr int LDS_BYTES = 147456;

__device__ __forceinline__ unsigned pk2(float lo, float hi) { unsigned r; asm volatile("v_cvt_pk_bf16_f32 %0, %1, %2" : "=v"(r) : "v"(lo), "v"(hi)); return r; }
__device__ __forceinline__ float bflo(unsigned w) { return __uint_as_float(w << 16); }
__device__ __forceinline__ float bfhi(unsigned w) { return __uint_as_float(w & 0xffff0000u); }
__device__ __forceinline__ float bf1(bf16_t b) { return __uint_as_float(((unsigned)b) << 16); }
__device__ __forceinline__ float rcpf_(float x) { return __builtin_amdgcn_rcpf(x); }
__device__ __forceinline__ float sigmoidf_(float x) { return __builtin_amdgcn_rcpf(1.0f + __expf(-x)); }
__device__ __forceinline__ float wave_sum(float v) {
#pragma unroll
    for (int o = 1; o < 64; o <<= 1) v += __shfl_xor(v, o);
    return v;
}
__device__ __forceinline__ s16x4 tr_read(const LAS unsigned char* p) {
    typedef short v4i16_t __attribute__((ext_vector_type(4)));
    return __builtin_bit_cast(s16x4, __builtin_amdgcn_ds_read_tr16_b64_v4i16((LAS v4i16_t*)p));
}


#define XB_TMO      128
#define XB_XCNT(j)  (256  + 64 * (j))
#define XB_XSUB(j)  (1280 + 64 * (j))
#define XB_XGEN(j)  (2304 + 64 * (j))
#define XB_TOP      3328
#define XB_TOPGEN   3392
#define XCD_BAR_WORDS 3456
#define XB_SPIN_CAP (1u << 22)
__device__ __forceinline__ unsigned xb_ld(unsigned* p)              { return __hip_atomic_load(p, __ATOMIC_RELAXED, __HIP_MEMORY_SCOPE_AGENT); }
__device__ __forceinline__ unsigned xb_add(unsigned* p, unsigned v) { return __hip_atomic_fetch_add(p, v, __ATOMIC_RELAXED, __HIP_MEMORY_SCOPE_AGENT); }
__device__ __forceinline__ unsigned xb_xcc_id() { return (unsigned)__builtin_amdgcn_s_getreg((3 << 11) | 20) & 0xFu; }
#define XB_SPIN(cond, bar) do { unsigned _sp = 0; while (cond) { __builtin_amdgcn_s_sleep(1); \
    if ((++_sp & 255u) == 0u) { if (xb_ld(&(bar)[XB_TMO])) break; if (_sp > XB_SPIN_CAP) { atomicAdd(&(bar)[XB_TMO], 1u); break; } } } } while (0)
struct XcdBarrier { unsigned* bar; unsigned x; volatile LAS unsigned* st; };
__device__ __forceinline__ XcdBarrier xcd_barrier_post(unsigned* bar, volatile LAS unsigned* st) {
    XcdBarrier b; b.bar = bar; b.x = xb_xcc_id(); b.st = st;
    if (threadIdx.x == 0) (void)xb_add(&bar[XB_XCNT(b.x)], 1u);
    return b;
}
__device__ __forceinline__ void xcd_barrier_complete(unsigned* bar, unsigned x, unsigned& nloc, unsigned& nx) {
    const unsigned G = gridDim.x * gridDim.y * gridDim.z;
    unsigned sum, cnt, mine, sp = 0u;
    for (;;) {
        sum = 0u; cnt = 0u; mine = 0u;
#pragma unroll
        for (unsigned j = 0; j < 16; ++j) { const unsigned c = xb_ld(&bar[XB_XCNT(j)]); sum += c; cnt += (c > 0u) ? 1u : 0u; mine = (j == x) ? c : mine; }
        if (sum == G) break;
        __builtin_amdgcn_s_sleep(1);
        if ((++sp & 255u) == 0u) { if (xb_ld(&bar[XB_TMO])) break; if (sp > XB_SPIN_CAP) { atomicAdd(&bar[XB_TMO], 1u); break; } }
    }
    nloc = mine > 0u ? mine : 1u; nx = cnt > 0u ? cnt : 1u;
}
__device__ __forceinline__ void xcd_barrier(unsigned* bar_, volatile LAS unsigned* st_) {
    XcdBarrier b; b.bar = bar_; b.st = st_; b.x = xb_xcc_id();
    asm volatile("s_waitcnt vmcnt(0)" ::: "memory");
    __syncthreads();
    if (threadIdx.x == 0) {
        unsigned* bar = b.bar;
        __builtin_amdgcn_s_waitcnt(0);
        unsigned nloc = b.st[0], nx = b.st[1];
        if (nloc == 0u) { xcd_barrier_complete(bar, b.x, nloc, nx); b.st[0] = nloc; b.st[1] = nx; }
        const unsigned old = xb_add(&bar[XB_XSUB(b.x)], 1u);
        const unsigned gen = old / nloc;
        if (old + 1u == (gen + 1u) * nloc) {
            __builtin_amdgcn_fence(__ATOMIC_RELEASE, "agent");
            asm volatile("s_waitcnt vmcnt(0)" ::: "memory");
            const unsigned og = xb_add(&bar[XB_TOP], 1u);
            const unsigned tg = og / nx;
            if (og + 1u == (tg + 1u) * nx) xb_add(&bar[XB_TOPGEN], 1u);
            else XB_SPIN(xb_ld(&bar[XB_TOPGEN]) == tg, bar);
            __builtin_amdgcn_fence(__ATOMIC_ACQUIRE, "agent");
            xb_add(&bar[XB_XGEN(b.x)], 1u);
            asm volatile("s_waitcnt vmcnt(0)" ::: "memory");
        } else {
            XB_SPIN(xb_ld(&bar[XB_XGEN(b.x)]) == gen, bar);
            __builtin_amdgcn_fence(__ATOMIC_ACQUIRE, "agent");
            asm volatile("s_waitcnt vmcnt(0)" ::: "memory");
        }
    }
    __syncthreads();
}

namespace pg8 {
constexpr int BM = 256, BK = 64, HALF = 128, HTB = HALF * BK * 2, STAGE_BYTES = 8 * HTB, NXCD = 8, WGM = 8;
__host__ __device__ __forceinline__ int lds_byte(int r, int c) { const int st = (r >> 4) * 2 + (c >> 5), rr = r & 15, cc = c & 31, ob = rr * 64 + cc * 2; return st * 1024 + (ob ^ (((ob >> 9) & 1) << 5)); }
__host__ __device__ __forceinline__ void stage_rc(int b, int& R, int& C) { const int st = b / 1024, sb = b % 1024, swz = sb ^ (((sb >> 9) & 1) << 5); R = (st >> 1) * 16 + swz / 64; C = (st & 1) * 32 + (swz % 64) / 2; }
__host__ __device__ __forceinline__ int perm32(int rho) { const int n = rho >> 4, i = rho & 15; return 8 * (i >> 2) + 4 * n + (i & 3); }

struct Unit { int pm, pn, seg; };
struct Gemm { const bf16_t* A[4]; const bf16_t* Bt[4]; int M, N, K;
    __device__ __forceinline__ const char* a(int sg) const { return (const char*)(sg == 0 ? A[0] : sg == 1 ? A[1] : sg == 2 ? A[2] : A[3]); }
    __device__ __forceinline__ const char* b(int sg) const { return (const char*)(sg == 0 ? Bt[0] : sg == 1 ? Bt[1] : sg == 2 ? Bt[2] : Bt[3]); } };

struct StaticOrder {
    int nM, nN, nwg, G, c, nseg, pm_off;
    __device__ void init(int M, int N, int G_, int c_, int nseg_, int pm_off_ = 0) { nM = M / BM; nN = N / BM; nwg = nM * nN; G = G_; c = c_; nseg = nseg_; pm_off = pm_off_; }
    __device__ bool next(int ii, Unit& u) const {
        const int i = ii / nseg; u.seg = ii - i * nseg;
        const long L = (long)i * G + c; if (L >= nwg) return false;
        int wgid = (int)L; { const int q = nwg / NXCD, r = nwg % NXCD, xcd = wgid % NXCD, off = wgid / NXCD; wgid = (xcd < r ? xcd * (q + 1) : r * (q + 1) + (xcd - r) * q) + off; }
        const int nig = WGM * nN, gid = wgid / nig, fm = gid * WGM, gsz = (nM - fm) < WGM ? (nM - fm) : WGM;
        u.pm = pm_off + fm + ((wgid % nig) % gsz); u.pn = (wgid % nig) / gsz; return true;
    }
};

template <class Epi, class Sched>
__device__ __forceinline__ void gemm_phase(LAS unsigned char* lds, const Gemm g, const Sched& S, const Epi& E) {
    const int tid = threadIdx.x, wid = __builtin_amdgcn_readfirstlane(tid >> 6), lane = tid & 63, wr = wid >> 2, wc = wid & 3, fr = lane & 15, fq = lane >> 4;
    const int K = g.K, nt = K / BK;
    unsigned voffA[2], voffB[2];
#pragma unroll
    for (int i = 0; i < 2; ++i) { int R, C; stage_rc(tid * 16 + i * 8192, R, C); const int Rb = Epi::PERM ? ((R & ~31) + perm32(R & 31)) : R;
        voffA[i] = (unsigned)(R * K + C) * 2u; voffB[i] = (unsigned)(Rb * K + C) * 2u; }
    const size_t kstep = (size_t)(BK * 2);
    const size_t hstep = (size_t)HALF * K * 2;
    const size_t tstep = 2 * hstep;
    const unsigned ldsw = (unsigned)wid * 1024u;
    const int aoff = lds_byte(wr * 64 + fr, fq * 8), boff = lds_byte(wc * 32 + fr, fq * 8);
#define PG8_SA(b, h) (((b) * 2 + (h)) * HTB)
#define PG8_SB(b, h) ((4 + (b) * 2 + (h)) * HTB)
#define PG8_STAGE(bufoff, gbase, voff) do { _Pragma("unroll") for (int _i = 0; _i < 2; ++_i) \
        __builtin_amdgcn_global_load_lds((const unsigned*)((const char*)(gbase) + (voff)[_i]), (LAS unsigned*)(lds + (bufoff) + ldsw + _i * 8192), 16, 0, 0); } while (0)
#define PG8_LDA(dst, b, h) do { _Pragma("unroll") for (int m = 0; m < 4; ++m) _Pragma("unroll") for (int k = 0; k < 2; ++k) dst[m][k] = *(const LAS bf16x8*)(lds + PG8_SA(b, h) + aoff + m * 2048 + k * 1024); } while (0)
#define PG8_LDB(dst, b, h) do { _Pragma("unroll") for (int n = 0; n < 2; ++n) _Pragma("unroll") for (int k = 0; k < 2; ++k) dst[n][k] = *(const LAS bf16x8*)(lds + PG8_SB(b, h) + boff + n * 2048 + k * 1024); } while (0)
#define PG8_MMA(ai, bj, At, Bt) do { __builtin_amdgcn_s_setprio(1); _Pragma("unroll") for (int m = 0; m < 4; ++m) _Pragma("unroll") for (int n = 0; n < 2; ++n) _Pragma("unroll") for (int k = 0; k < 2; ++k) \
        acc[ai][bj][m][n] = __builtin_amdgcn_mfma_f32_16x16x32_bf16(Bt[n][k], At[m][k], acc[ai][bj][m][n], 0, 0, 0); __builtin_amdgcn_s_setprio(0); } while (0)
#define PG8_WAIT_V(n) asm volatile("s_waitcnt vmcnt(" #n ")" ::: "memory")
#define PG8_WAIT_L(n) asm volatile("s_waitcnt lgkmcnt(" #n ")" ::: "memory")
#define PG8_BAR __builtin_amdgcn_s_barrier()
#define PG8_SCHED __builtin_amdgcn_sched_barrier(0)
    Unit cur, nxt; int ui = 0;
    if (!S.next(0, cur)) return;
    f32x4 acc[2][2][4][2];
#pragma unroll
    for (int a = 0; a < 2; ++a)
#pragma unroll
        for (int b = 0; b < 2; ++b)
#pragma unroll
            for (int m = 0; m < 4; ++m)
#pragma unroll
                for (int n = 0; n < 2; ++n) acc[a][b][m][n] = (f32x4){0.f, 0.f, 0.f, 0.f};
    bf16x8 At[4][2], B0[2][2], B1[2][2];
    const char* cA = g.a(cur.seg) + (size_t)cur.pm * tstep; const char* cB = g.b(cur.seg) + (size_t)cur.pn * tstep;
    PG8_STAGE(PG8_SB(0, 0), cB, voffB); PG8_STAGE(PG8_SB(0, 1), cB + hstep, voffB); PG8_STAGE(PG8_SA(0, 0), cA, voffA); PG8_STAGE(PG8_SA(0, 1), cA + hstep, voffA);
    if (wr == 1) PG8_BAR;
    PG8_WAIT_V(2); PG8_BAR;
    PG8_STAGE(PG8_SB(1, 0), cB + kstep, voffB); PG8_STAGE(PG8_SA(1, 0), cA + kstep, voffA); PG8_STAGE(PG8_SB(1, 1), cB + hstep + kstep, voffB);
    PG8_WAIT_V(6); PG8_BAR;
    for (;;) {
        const bool has_next = S.next(ui + 1, nxt);
        const char* nA = has_next ? g.a(nxt.seg) + (size_t)nxt.pm * tstep : cA; const char* nB = has_next ? g.b(nxt.seg) + (size_t)nxt.pn * tstep : cB;
        for (int t = 0; t < nt; t += 2) {
            const bool last = (t == nt - 2);
            const char* a1 = cA + (size_t)(t + 1) * kstep;
            const char* a2 = last ? nA : cA + (size_t)(t + 2) * kstep; const char* b2 = last ? nB : cB + (size_t)(t + 2) * kstep;
            const char* a3 = a2 + kstep; const char* b3 = b2 + kstep;
            PG8_LDB(B0, 0, 0); PG8_LDB(B1, 0, 1); PG8_SCHED; PG8_LDA(At, 0, 0); PG8_STAGE(PG8_SA(1, 1), a1 + hstep, voffA);
            PG8_WAIT_V(8); PG8_WAIT_L(0); PG8_BAR; PG8_MMA(0, 0, At, B0); PG8_MMA(0, 1, At, B1); PG8_BAR; PG8_SCHED;
            PG8_LDA(At, 0, 1); PG8_STAGE(PG8_SB(0, 0), b2, voffB); PG8_STAGE(PG8_SB(0, 1), b2 + hstep, voffB); PG8_STAGE(PG8_SA(0, 0), a2, voffA);
            PG8_WAIT_V(8); PG8_WAIT_L(0); PG8_BAR; PG8_MMA(1, 0, At, B0); PG8_MMA(1, 1, At, B1); PG8_BAR; PG8_SCHED;
            PG8_LDB(B0, 1, 0); PG8_LDB(B1, 1, 1); PG8_SCHED; PG8_LDA(At, 1, 0); PG8_STAGE(PG8_SA(0, 1), a2 + hstep, voffA);
            PG8_WAIT_V(8); PG8_WAIT_L(0); PG8_BAR; PG8_MMA(0, 0, At, B0); PG8_MMA(0, 1, At, B1); PG8_BAR; PG8_SCHED;
            PG8_LDA(At, 1, 1); PG8_STAGE(PG8_SB(1, 0), b3, voffB); PG8_STAGE(PG8_SB(1, 1), b3 + hstep, voffB); PG8_STAGE(PG8_SA(1, 0), a3, voffA);
            PG8_WAIT_V(8); PG8_WAIT_L(0); PG8_BAR; PG8_MMA(1, 0, At, B0); PG8_MMA(1, 1, At, B1); PG8_BAR; PG8_SCHED;
        }
        if (wr == 0) PG8_BAR;
        E(acc, cur, wr, wc, fr, fq);
        if (!has_next) break;
        if (!(Epi::KEEP && E.keep(cur))) {
#pragma unroll
            for (int a = 0; a < 2; ++a)
#pragma unroll
                for (int b = 0; b < 2; ++b)
#pragma unroll
                    for (int m = 0; m < 4; ++m)
#pragma unroll
                        for (int n = 0; n < 2; ++n) acc[a][b][m][n] = (f32x4){0.f, 0.f, 0.f, 0.f};
        }
        cur = nxt; cA = nA; cB = nB; ++ui;
        if (wr == 1) PG8_BAR;
    }
    PG8_WAIT_V(0);
    PG8_BAR;
#undef PG8_SA
#undef PG8_SB
#undef PG8_STAGE
#undef PG8_LDA
#undef PG8_LDB
#undef PG8_MMA
#undef PG8_WAIT_V
#undef PG8_WAIT_L
#undef PG8_BAR
#undef PG8_SCHED
}

struct EpiSwiglu {
    static constexpr bool PERM = true, KEEP = false;
    bf16_t* O;
    __device__ __forceinline__ bool keep(const Unit&) const { return false; }
    __device__ __forceinline__ void operator()(f32x4 (&acc)[2][2][4][2], const Unit& u, int wr, int wc, int fr, int fq) const {
        const int row0 = u.pm * BM + wr * 64 + fr, col0 = u.pn * 128 + wc * 32 + 8 * fq;
#pragma unroll
        for (int ai = 0; ai < 2; ++ai)
#pragma unroll
            for (int m = 0; m < 4; ++m) {
                bf16_t* rowp = O + (size_t)(row0 + ai * HALF + m * 16) * FF + col0;
                float v[8];
#pragma unroll
                for (int n = 0; n < 2; ++n)
#pragma unroll
                    for (int i = 0; i < 4; ++i) { const float gt = acc[ai][0][m][n][i], up = acc[ai][1][m][n][i]; v[n * 4 + i] = gt * sigmoidf_(gt) * up; }
                u32x4 w; w.x = pk2(v[0], v[1]); w.y = pk2(v[2], v[3]); w.z = pk2(v[4], v[5]); w.w = pk2(v[6], v[7]);
                *(u32x4*)rowp = w;
            }
    }
};
struct EpiResid {
    static constexpr bool PERM = false, KEEP = false;
    bf16_t* U; const float* xp; const float* xs; const bf16_t* hb; float scale; int mode;
    __device__ __forceinline__ bool keep(const Unit&) const { return false; }
    __device__ __forceinline__ void operator()(f32x4 (&acc)[2][2][4][2], const Unit& u, int wr, int wc, int fr, int fq) const {
        const int row0 = u.pm * BM + wr * 64 + fr, col0 = u.pn * BM + wc * 32 + 4 * fq;
#pragma unroll
        for (int ai = 0; ai < 2; ++ai)
#pragma unroll
            for (int m = 0; m < 4; ++m) {
                const int r = row0 + ai * HALF + m * 16;
                bf16_t* op = U + (size_t)r * DM;
                if (mode == 0) {
                    const float* bp = (r < TP ? xp + (size_t)r * DM : xs + (size_t)(r - TP) * DM);
#pragma unroll
                    for (int bj = 0; bj < 2; ++bj)
#pragma unroll
                        for (int n = 0; n < 2; ++n) { const int c = col0 + bj * HALF + n * 16; const f32x4 b = *(const f32x4*)(bp + c); const f32x4 o = b * ALPHA + acc[ai][bj][m][n] * scale; *(u32x2*)(op + c) = (u32x2){pk2(o[0], o[1]), pk2(o[2], o[3])}; }
                } else {
                    const bf16_t* bp = hb + (size_t)r * DM;
#pragma unroll
                    for (int bj = 0; bj < 2; ++bj)
#pragma unroll
                        for (int n = 0; n < 2; ++n) { const int c = col0 + bj * HALF + n * 16; const u32x2 w = *(const u32x2*)(bp + c);
                            const f32x4 b = (f32x4){bflo(w.x), bfhi(w.x), bflo(w.y), bfhi(w.y)}; const f32x4 o = b * ALPHA + acc[ai][bj][m][n] * scale; *(u32x2*)(op + c) = (u32x2){pk2(o[0], o[1]), pk2(o[2], o[3])}; }
                }
            }
    }
};
struct EpiSplitBf16 {
    static constexpr bool PERM = true, KEEP = false;
    bf16_t* dst[7]; float* pk; float* sk; float* pv; float* sv; int kt, vt;
    __device__ __forceinline__ bool keep(const Unit&) const { return false; }
    __device__ __forceinline__ void operator()(f32x4 (&acc)[2][2][4][2], const Unit& u, int wr, int wc, int fr, int fq) const {
        const int t = u.pn >> 2; bf16_t* base = (t == 0 ? dst[0] : t == 1 ? dst[1] : t == 2 ? dst[2] : t == 3 ? dst[3] : t == 4 ? dst[4] : t == 5 ? dst[5] : dst[6]);
        const int row0 = u.pm * BM + wr * 64 + fr, col0 = (u.pn & 3) * BM + wc * 32 + 8 * fq;
        float* fbase = nullptr;
        if (t == kt || t == vt) {
            if (u.pm >= 256) fbase = (t == kt ? sk : sv) + (size_t)(u.pm * BM - TP) * DM;
            else if ((u.pm & 7) >= 6) fbase = (t == kt ? pk : pv) + ((size_t)(u.pm >> 3) * 512 + (size_t)((u.pm & 7) - 6) * 256) * DM;
        }
#pragma unroll
        for (int ai = 0; ai < 2; ++ai)
#pragma unroll
            for (int m = 0; m < 4; ++m) {
                const int r = row0 + ai * HALF + m * 16;
                bf16_t* rowp = base + (size_t)r * DM + col0;
#pragma unroll
                for (int bj = 0; bj < 2; ++bj) {
                    const f32x4 v0 = acc[ai][bj][m][0], v1 = acc[ai][bj][m][1];
                    u32x4 w; w.x = pk2(v0[0], v0[1]); w.y = pk2(v0[2], v0[3]); w.z = pk2(v1[0], v1[1]); w.w = pk2(v1[2], v1[3]);
                    *(u32x4*)(rowp + bj * HALF) = w;
                    if (fbase) { float* fp = fbase + (size_t)(r - u.pm * BM) * DM + col0 + bj * HALF; *(f32x4*)fp = v0; *(f32x4*)(fp + 4) = v1; }
                }
            }
    }
};
struct EpiMerge {
    static constexpr bool PERM = true, KEEP = false;
    bf16_t* MG; u32x4* scr;
    __device__ __forceinline__ bool keep(const Unit&) const { return false; }
    __device__ __forceinline__ void operator()(const f32x4 (&acc)[2][2][4][2], const Unit& u, int wr, int wc, int fr, int fq) const {
        const int tid = threadIdx.x;
        const int row0 = u.pm * BM + wr * 64 + fr, col0 = u.pn * BM + wc * 32 + 8 * fq;
#define PINP(x) asm volatile("" : "+v"(x))
        if (u.seg == 0 || u.seg == 2) {
            int qa = tid; PINP(qa);
#pragma unroll
            for (int k = 0; k < 16; ++k) {
                const f32x4 v0 = acc[k >> 3][k & 1][(k >> 1) & 3][0], v1 = acc[k >> 3][k & 1][(k >> 1) & 3][1];
                u32x4 w; w.x = pk2(sigmoidf_(v0[0]), sigmoidf_(v0[1])); w.y = pk2(sigmoidf_(v0[2]), sigmoidf_(v0[3]));
                w.z = pk2(sigmoidf_(v1[0]), sigmoidf_(v1[1])); w.w = pk2(sigmoidf_(v1[2]), sigmoidf_(v1[3]));
                scr[qa] = w; qa += 512; PINP(qa);
            }
        } else if (u.seg == 1) {
            int qa = tid, qc = tid + 16 * 512; PINP(qa); PINP(qc);
#pragma unroll
            for (int k = 0; k < 16; ++k) {
                const f32x4 v0 = acc[k >> 3][k & 1][(k >> 1) & 3][0], v1 = acc[k >> 3][k & 1][(k >> 1) & 3][1];
                const u32x4 a = scr[qa];
                const f32x4 c0 = (f32x4){v0[0] * bflo(a.x), v0[1] * bfhi(a.x), v0[2] * bflo(a.y), v0[3] * bfhi(a.y)};
                const f32x4 c1 = (f32x4){v1[0] * bflo(a.z), v1[1] * bfhi(a.z), v1[2] * bflo(a.w), v1[3] * bfhi(a.w)};
                scr[qc] = (u32x4){pk2(c0[0], c0[1]), pk2(c0[2], c0[3]), pk2(c1[0], c1[1]), pk2(c1[2], c1[3])};
                qa += 512; qc += 512; PINP(qa); PINP(qc);
            }
        } else {
            int qa = tid, qc = tid + 16 * 512; PINP(qa); PINP(qc);
            int mo = row0 * DM + col0; PINP(mo);
#pragma unroll
            for (int k = 0; k < 16; ++k) {
                const int ai = k >> 3, bj = k & 1, m = (k >> 1) & 3;
                const f32x4 v0 = acc[ai][bj][m][0], v1 = acc[ai][bj][m][1];
                const u32x4 b = scr[qa];
                const u32x4 cw = scr[qc];
                const f32x4 c0 = (f32x4){bflo(cw.x), bfhi(cw.x), bflo(cw.y), bfhi(cw.y)}, c1 = (f32x4){bflo(cw.z), bfhi(cw.z), bflo(cw.w), bfhi(cw.w)};
                u32x4 w; w.x = pk2(c0[0] + v0[0] * bflo(b.x), c0[1] + v0[1] * bfhi(b.x)); w.y = pk2(c0[2] + v0[2] * bflo(b.y), c0[3] + v0[3] * bfhi(b.y));
                w.z = pk2(c1[0] + v1[0] * bflo(b.z), c1[1] + v1[1] * bfhi(b.z)); w.w = pk2(c1[2] + v1[2] * bflo(b.w), c1[3] + v1[3] * bfhi(b.w));
                *(u32x4*)(MG + mo + (ai * HALF + m * 16) * DM + bj * HALF) = w;
                qa += 512; qc += 512; PINP(qa); PINP(qc);
            }
        }
#undef PINP
    }
};
}

struct Args {
    const float* in[28];
    float* out; unsigned char* ws;
    int ph_lo, ph_hi;
};
enum { I_XP = 0, I_XS, I_SCONV, I_SC, I_SN, I_SM, I_CK, I_CV, I_WIN, I_BI, I_BF, I_CONVW, I_CONVB, I_MLNG, I_RELB, I_WMLP, I_WATTP, I_WOUT,
       I_GU1, I_D1, I_GU2, I_D2, I_LN1G, I_LN1B, I_LN2G, I_LN2B, I_LN3G, I_LN3B };

__device__ __forceinline__ void transpose_item(const float* W, int ldw, int col0, int K, int N, bf16_t* WT, int mode, LAS float* scr, int item, int lane) {
    const int nblk = N / 32, kb = item / nblk, nb = item % nblk, k0 = 64 * kb, n0 = 32 * nb;
    {
        const int n4 = (lane & 7) * 4, kq = lane >> 3;
        f32x4 wv[8];
#pragma unroll
        for (int i = 0; i < 8; ++i) wv[i] = *(const f32x4*)(W + (size_t)(k0 + kq + 8 * i) * ldw + col0 + n0 + n4);
#pragma unroll
        for (int i = 0; i < 8; ++i) { LAS float* d = scr + (kq + 8 * i) * 33 + n4; d[0] = wv[i][0]; d[1] = wv[i][1]; d[2] = wv[i][2]; d[3] = wv[i][3]; }
    }
    asm volatile("s_waitcnt lgkmcnt(0)" ::: "memory");
    const int c = lane & 7;
#pragma unroll
    for (int j = 0; j < 4; ++j) { const int nn = (lane >> 3) + 8 * j; const LAS float* s = scr + (8 * c) * 33 + nn;
        u32x4 o; o.x = pk2(s[0 * 33], s[1 * 33]); o.y = pk2(s[2 * 33], s[3 * 33]); o.z = pk2(s[4 * 33], s[5 * 33]); o.w = pk2(s[6 * 33], s[7 * 33]);
        const int n = n0 + nn;
        const int drow = (mode == 1) ? (256 * ((n % FF) / 128) + 128 * (n / FF) + (n % 128)) : n;
        *(u32x4*)(WT + (size_t)drow * K + k0 + 8 * c) = o; }
    asm volatile("s_waitcnt lgkmcnt(0)" ::: "memory");
}
__device__ __forceinline__ void cvt_f32_bf16(const float* src, bf16_t* dst, size_t n8, size_t i0, size_t stride) {
    for (size_t i = i0; i < n8; i += stride) {
        const f32x4 a = *(const f32x4*)(src + i * 8), b = *(const f32x4*)(src + i * 8 + 4);
        u32x4 w; w.x = pk2(a[0], a[1]); w.y = pk2(a[2], a[3]); w.z = pk2(b[0], b[1]); w.w = pk2(b[2], b[3]);
        *(u32x4*)(dst + i * 8) = w;
    }
}
__device__ __forceinline__ void p0_prologue(const Args& a, LAS unsigned char* lds) {
    const int tid = threadIdx.x, lane = tid & 63, wave = tid >> 6;
    LAS float* scr = (LAS float*)(lds + wave * 16384);
    const int gw = blockIdx.x * 8 + wave, NGW = gridDim.x * 8;
    unsigned char* ws = a.ws;
    constexpr int I_GU = (DM / 64) * (2 * FF / 32), I_DN = (FF / 64) * (DM / 32), I_ML = (DM / 64) * (4096 / 32), I_AT = (DM / 64) * (3072 / 32), I_SQ = (DM / 64) * (DM / 32);
    constexpr int NITEMS = 2 * I_GU + 2 * I_DN + I_ML + I_AT + 5 * I_SQ;
    for (int it = gw; it < NITEMS; it += NGW) {
        int r = it;
        if (r < I_GU) { transpose_item(a.in[I_GU1], 2 * FF, 0, DM, 2 * FF, (bf16_t*)(ws + WS_WGU1), 1, scr, r, lane); continue; } r -= I_GU;
        if (r < I_GU) { transpose_item(a.in[I_GU2], 2 * FF, 0, DM, 2 * FF, (bf16_t*)(ws + WS_WGU2), 1, scr, r, lane); continue; } r -= I_GU;
        if (r < I_DN) { transpose_item(a.in[I_D1], DM, 0, FF, DM, (bf16_t*)(ws + WS_WD1), 0, scr, r, lane); continue; } r -= I_DN;
        if (r < I_DN) { transpose_item(a.in[I_D2], DM, 0, FF, DM, (bf16_t*)(ws + WS_WD2), 0, scr, r, lane); continue; } r -= I_DN;
        if (r < I_ML) { transpose_item(a.in[I_WIN], INW, 0, DM, 4096, (bf16_t*)(ws + WS_WML), 0, scr, r, lane); continue; } r -= I_ML;
        if (r < I_AT) { transpose_item(a.in[I_WIN], INW, 4104, DM, 3072, (bf16_t*)(ws + WS_WATT), 0, scr, r, lane); continue; } r -= I_AT;
        if (r < I_SQ) { transpose_item(a.in[I_WIN], INW, 7176, DM, DM, (bf16_t*)(ws + WS_WGM), 0, scr, r, lane); continue; } r -= I_SQ;
        if (r < I_SQ) { transpose_item(a.in[I_WIN], INW, 8200, DM, DM, (bf16_t*)(ws + WS_WGA), 0, scr, r, lane); continue; } r -= I_SQ;
        if (r < I_SQ) { transpose_item(a.in[I_WMLP], DM, 0, DM, DM, (bf16_t*)(ws + WS_WMLP), 0, scr, r, lane); continue; } r -= I_SQ;
        if (r < I_SQ) { transpose_item(a.in[I_WATTP], DM, 0, DM, DM, (bf16_t*)(ws + WS_WATTP), 0, scr, r, lane); continue; } r -= I_SQ;
        transpose_item(a.in[I_WOUT], DM, 0, DM, DM, (bf16_t*)(ws + WS_WOUT), 0, scr, r, lane);
    }
    const size_t gt = (size_t)blockIdx.x * 512 + tid, NT = (size_t)gridDim.x * 512;
    for (size_t i = gt; i < 8 * 1024; i += NT) { const int c = (int)(i >> 10), k = (int)(i & 1023); ((float*)(ws + WS_WIF))[i] = a.in[I_WIN][(size_t)k * INW + 4096 + c]; }
    cvt_f32_bf16(a.in[I_XP], (bf16_t*)(ws + WS_HB), (size_t)TP * DM / 8, gt, NT);
    cvt_f32_bf16(a.in[I_XS], (bf16_t*)(ws + WS_HB) + (size_t)TP * DM, (size_t)TS * DM / 8, gt, NT);
}

template <int MODE>
__device__ __forceinline__ void ln_pass(const bf16_t* Ub, float* Yout, bf16_t* HB, const float* g, const float* bta, const float* WIF, float* IFo, int row_lo, int row_hi, int cu_lo, int ncu) {
    int tid = threadIdx.x; asm volatile("" : "+v"(tid)); const int lane = tid & 63, wave = tid >> 6;
    const int gw = ((int)blockIdx.x - cu_lo) * 8 + wave, NGW = ncu * 8;
    if (gw < 0 || gw >= NGW) return;
    constexpr int R = 2;
    f32x4 gg[4], bb[4];
#pragma unroll
    for (int j = 0; j < 4; ++j) { gg[j] = *(const f32x4*)(g + 4 * lane + 256 * j); bb[j] = *(const f32x4*)(bta + 4 * lane + 256 * j); }
    f32x4 wif[MODE == 1 ? 8 : 1][4];
    if (MODE == 1) {
#pragma unroll
        for (int c = 0; c < 8; ++c)
#pragma unroll
            for (int j = 0; j < 4; ++j) wif[c][j] = *(const f32x4*)(WIF + c * 1024 + 4 * lane + 256 * j);
    }
    for (int row0 = row_lo + gw * R; row0 < row_hi; row0 += NGW * R) {
        f32x4 v[R][4]; float s[R], s2[R];
#pragma unroll
        for (int r = 0; r < R; ++r) {
            const bf16_t* ur = Ub + (size_t)(row0 + r) * DM + 4 * lane;
#pragma unroll
            for (int j = 0; j < 4; ++j) { const u32x2 w = *(const u32x2*)(ur + 256 * j); v[r][j] = (f32x4){bflo(w.x), bfhi(w.x), bflo(w.y), bfhi(w.y)}; }
        }
#pragma unroll
        for (int r = 0; r < R; ++r) { s[r] = 0.f;
#pragma unroll
            for (int j = 0; j < 4; ++j) s[r] += (v[r][j][0] + v[r][j][1]) + (v[r][j][2] + v[r][j][3]); }
#pragma unroll
        for (int o = 1; o < 64; o <<= 1) {
#pragma unroll
            for (int r = 0; r < R; ++r) s[r] += __shfl_xor(s[r], o); }
#pragma unroll
        for (int r = 0; r < R; ++r) { const float mean = s[r] * (1.f / DM); s2[r] = 0.f;
#pragma unroll
            for (int j = 0; j < 4; ++j) { v[r][j] = v[r][j] - mean; s2[r] += (v[r][j][0] * v[r][j][0] + v[r][j][1] * v[r][j][1]) + (v[r][j][2] * v[r][j][2] + v[r][j][3] * v[r][j][3]); } }
#pragma unroll
        for (int o = 1; o < 64; o <<= 1) {
#pragma unroll
            for (int r = 0; r < R; ++r) s2[r] += __shfl_xor(s2[r], o); }
#pragma unroll
        for (int r = 0; r < R; ++r) {
            const float rstd = 1.f / sqrtf(s2[r] * (1.f / DM) + LN_EPS);
#pragma unroll
            for (int j = 0; j < 4; ++j) v[r][j] = v[r][j] * rstd * gg[j] + bb[j];
            if (MODE == 3) {
                float* ur = Yout + (size_t)(row0 + r) * DM + 4 * lane;
#pragma unroll
                for (int j = 0; j < 4; ++j) *(f32x4*)(ur + 256 * j) = v[r][j];
            } else {
                bf16_t* hr = HB + (size_t)(row0 + r) * DM + 4 * lane;
#pragma unroll
                for (int j = 0; j < 4; ++j) { u32x2 w; w.x = pk2(v[r][j][0], v[r][j][1]); w.y = pk2(v[r][j][2], v[r][j][3]); *(u32x2*)(hr + 256 * j) = w; }
            }
        }
        if (MODE == 1) {
#pragma unroll
            for (int r = 0; r < R; ++r) {
                float d[8];
#pragma unroll
                for (int c = 0; c < 8; ++c) { d[c] = 0.f;
#pragma unroll
                    for (int j = 0; j < 4; ++j) { const f32x4 w = wif[MODE == 1 ? c : 0][j]; d[c] += (v[r][j][0] * w[0] + v[r][j][1] * w[1]) + (v[r][j][2] * w[2] + v[r][j][3] * w[3]); } }
                const bool b0 = lane & 1, b1 = lane & 2, b2 = lane & 4;
                float e[4], f[2], hsum;
#pragma unroll
                for (int i = 0; i < 4; ++i) { const float t_ = __shfl_xor(b0 ? d[i] : d[i + 4], 1); e[i] = (b0 ? d[i + 4] : d[i]) + t_; }
#pragma unroll
                for (int i = 0; i < 2; ++i) { const float t_ = __shfl_xor(b1 ? e[i] : e[i + 2], 2); f[i] = (b1 ? e[i + 2] : e[i]) + t_; }
                { const float t_ = __shfl_xor(b2 ? f[0] : f[1], 4); hsum = (b2 ? f[1] : f[0]) + t_; }
                hsum += __shfl_xor(hsum, 8); hsum += __shfl_xor(hsum, 16); hsum += __shfl_xor(hsum, 32);
                const int col = (b0 ? 4 : 0) + (b1 ? 2 : 0) + (b2 ? 1 : 0);
                if (lane < 8) IFo[(size_t)(row0 + r) * 8 + col] = hsum;
            }
        }
    }
}

__device__ __forceinline__ void headln_pass(bf16_t* H, const bf16_t* MLO, const float* ng) {
    int tid = threadIdx.x; asm volatile("" : "+v"(tid)); const int lane = tid & 63, wave = tid >> 6;
    const int gw = blockIdx.x * 8 + wave, NGW = gridDim.x * 8;
    const int c0 = (lane >> 4) * 256 + (lane & 15) * 16;
    float gv[16];
#pragma unroll
    for (int i = 0; i < 16; ++i) gv[i] = ng[c0 + i];
    for (int rowb = gw; rowb < TT; rowb += 2 * NGW) {
        u32x4 a0[2], a1[2], o0[2], o1[2];
#pragma unroll
        for (int q = 0; q < 2; ++q) {
            const int row = (rowb + q * NGW < TT) ? rowb + q * NGW : rowb;
            a0[q] = *(const u32x4*)(H + (size_t)row * DM + c0); a1[q] = *(const u32x4*)(H + (size_t)row * DM + c0 + 8);
            o0[q] = *(const u32x4*)(MLO + (size_t)row * DM + c0); o1[q] = *(const u32x4*)(MLO + (size_t)row * DM + c0 + 8);
        }
#pragma unroll
        for (int q = 0; q < 2; ++q) {
            const int row = rowb + q * NGW;
            float v[16], og[16];
            const unsigned aw[8] = {a0[q].x, a0[q].y, a0[q].z, a0[q].w, a1[q].x, a1[q].y, a1[q].z, a1[q].w}, ow[8] = {o0[q].x, o0[q].y, o0[q].z, o0[q].w, o1[q].x, o1[q].y, o1[q].z, o1[q].w};
#pragma unroll
            for (int i = 0; i < 8; ++i) { v[2 * i] = bflo(aw[i]); v[2 * i + 1] = bfhi(aw[i]); og[2 * i] = bflo(ow[i]); og[2 * i + 1] = bfhi(ow[i]); }
            float sm = 0.f;
#pragma unroll
            for (int i = 0; i < 16; ++i) sm += v[i];
#pragma unroll
            for (int o = 1; o < 16; o <<= 1) sm += __shfl_xor(sm, o);
            const float mean = sm * (1.f / 256.f); float s2 = 0.f;
#pragma unroll
            for (int i = 0; i < 16; ++i) { v[i] -= mean; s2 += v[i] * v[i]; }
#pragma unroll
            for (int o = 1; o < 16; o <<= 1) s2 += __shfl_xor(s2, o);
            const float rstd = 1.f / sqrtf(s2 * (1.f / 256.f) + LN_EPS);
            unsigned w[8];
#pragma unroll
            for (int i = 0; i < 8; ++i) w[i] = pk2(v[2 * i] * rstd * gv[2 * i] * sigmoidf_(og[2 * i]), v[2 * i + 1] * rstd * gv[2 * i + 1] * sigmoidf_(og[2 * i + 1]));
            if (row < TT) {
                *(u32x4*)(H + (size_t)row * DM + c0) = (u32x4){w[0], w[1], w[2], w[3]};
                *(u32x4*)(H + (size_t)row * DM + c0 + 8) = (u32x4){w[4], w[5], w[6], w[7]};
            }
        }
    }
}

namespace ml {
constexpr int QS = 0, KS = 35840, VS = 71680, VW = 91136, PS = 110592, CW = 119808, NV = 130048, SC = 131072;
constexpr int QROW = 560, VROW = 304, PROW = 144;
constexpr int S_A = 0, S_PM = 256, S_WI = 512, S_EMT = 768, S_WS = 1024, S_RS0 = 1280, S_RS1 = 1536, S_QN = 1792, S_DEC = 2048, S_PAR = 2304;
static_assert(KS - QS >= 64 * QROW && VS - KS >= 64 * QROW && VW - VS >= 64 * VROW && PS - VW >= 64 * VROW && CW - PS >= 64 * PROW && NV - CW >= 10240 && SC - NV >= 1024 && SC + 2 * S_PAR <= LDS_BYTES - 64, "mlstm lds");

__device__ __forceinline__ void mlstm_item(const Args& a, LAS unsigned char* lds, int item) {
    const int tid = threadIdx.x, lane = tid & 63, wid = __builtin_amdgcn_readfirstlane(tid >> 6), fr = lane & 15, g = lane >> 4;
    const bool sample = item >= 256; const int it = sample ? item - 256 : item;
    const int b = it >> 3, h = (it >> 1) & 3, half = it & 1;
    const int row0 = sample ? TP + b * DSEQ : b * SEQ, nch = sample ? 1 : SEQ / 64;
    unsigned char* ws = a.ws;
    const bf16_t* MLQ = (const bf16_t*)(ws + WS_B0); const bf16_t* MLK = (const bf16_t*)(ws + WS_B0 + SZ1); const bf16_t* MLV = (const bf16_t*)(ws + WS_B0 + 2 * SZ1);
    const float* IFb = (const float*)(ws + WS_IF);
    float* out = a.out;
    const int e0 = 16 * wid;
    const int ecol = h * 256 + half * 128;
    LAS float* cw = (LAS float*)(lds + CW);
    for (int i = tid; i < 2 * 5 * 256; i += 512) { const int mat = i / 1280, r = (i % 1280) / 256, ch = i & 255; const int gc = mat * 1024 + h * 256 + ch;
        cw[i] = (r < 4) ? a.in[I_CONVW][r * 2048 + gc] : a.in[I_CONVB][gc]; }
    LAS float* nv = (LAS float*)(lds + NV);
    if (tid < 256) nv[tid] = sample ? a.in[I_SN][(b * 4 + h) * 256 + tid] : 0.f;
    f32x4 accC[16];
#pragma unroll
    for (int dt = 0; dt < 16; ++dt) accC[dt] = (f32x4){0.f, 0.f, 0.f, 0.f};
    if (sample) {
#pragma unroll
        for (int dt = 0; dt < 16; ++dt) { const float* cp = a.in[I_SC] + ((size_t)(b * 4 + h) * 256 + 16 * dt + 4 * g) * 256 + half * 128 + e0 + fr;
            accC[dt] = (f32x4){cp[0], cp[256], cp[512], cp[768]}; }
    }
    for (int i = tid; i < 2 * 3 * 256; i += 512) { const int mat = i / 768, r = (i % 768) / 256, ch = i & 255;
        const float v = sample ? a.in[I_SCONV][((size_t)b * 3 + r) * 2048 + mat * 1024 + h * 256 + ch] : 0.f;
        *(LAS bf16_t*)(lds + PS + i * 2) = (bf16_t)(pk2(v, 0.f) & 0xffffu); }
    float mstate = sample ? a.in[I_SM][b * 4 + h] : 0.f;
    const float bi = __int_as_float(__builtin_amdgcn_readfirstlane(__float_as_int(a.in[I_BI][h]))), bfg = __int_as_float(__builtin_amdgcn_readfirstlane(__float_as_int(a.in[I_BF][h])));
    __syncthreads();
    const int cmat = tid >> 8, chp2 = (tid & 127) * 2, rh = (tid >> 7) & 1;
    const int eg8 = (tid & 15) * 8, vr0 = 4 * ((tid >> 4) & 15);
    unsigned raw[35];
    {
        const bf16_t* src = (cmat ? MLK : MLQ) + h * 256 + chp2;
#pragma unroll
        for (int r = 0; r < 35; ++r) { int t = 32 * rh - 3 + r; if (t < 0) t = 0; raw[r] = *(const unsigned*)(src + ((size_t)row0 + t) * DM); }
        if (rh == 0) {
#pragma unroll
            for (int r = 0; r < 3; ++r) raw[r] = *(const LAS unsigned*)(lds + PS + (cmat * 768 + r * 256 + chp2) * 2);
        }
    }
    float pxi = 0.f, pxf = 0.f;
    if (wid == 0) { pxi = IFb[((size_t)row0 + lane) * 8 + h]; pxf = IFb[((size_t)row0 + lane) * 8 + 4 + h]; }
    for (int c = 0; c < nch; ++c) {
        const int par = c & 1;
        LAS float* sc = (LAS float*)(lds + SC + par * S_PAR);
        const size_t rbase = (size_t)row0 + (size_t)c * 64;
        if (wid == 0) {
            const float xi = pxi + bi;
            const float xf = pxf + bfg;
            if (c + 1 < nch) { pxi = IFb[(rbase + 64 + lane) * 8 + h]; pxf = IFb[(rbase + 64 + lane) * 8 + 4 + h]; }
            const float lf = fminf(xf, 0.f) - __logf(1.0f + __expf(-fabsf(xf)));
            float bc = lf;
#pragma unroll
            for (int o = 1; o < 64; o <<= 1) { const float t_ = __shfl_up(bc, o); if (lane >= o) bc += t_; }
            const float av = xi - bc;
            float pmx = av;
#pragma unroll
            for (int o = 1; o < 64; o <<= 1) { const float t_ = __shfl_up(pmx, o); if (lane >= o) pmx = fmaxf(pmx, t_); }
            pmx = fmaxf(pmx, mstate);
            const float pm63 = __shfl(pmx, 63), b63 = __shfl(bc, 63);
            sc[S_A / 4 + lane] = av; sc[S_PM / 4 + lane] = pmx; sc[S_WI / 4 + lane] = __expf(mstate - pmx); sc[S_EMT / 4 + lane] = __expf(-(bc + pmx));
            sc[S_WS / 4 + lane] = __expf(av - pm63);
            if (lane == 0) sc[S_DEC / 4] = __expf(mstate - pm63);
            mstate = __int_as_float(__builtin_amdgcn_readfirstlane(__float_as_int(b63 + pm63)));
        }
        const bool conv_out = (c == nch - 1 && half == 0 && rh == 1);
        __syncthreads();
#ifndef NO_CONV
        u32x4 rv[4];
        {
            if (conv_out) {
                float* co = out + (sample ? O_SCONV : O_PCONV) + (size_t)b * 3 * 2048 + cmat * 1024 + h * 256 + chp2;
#pragma unroll
                for (int j = 0; j < 3; ++j) { const unsigned x = raw[32 + j]; co[j * 2048] = bflo(x); co[j * 2048 + 1] = bfhi(x); }
            }
            const LAS float* w = cw + cmat * 1280 + chp2;
            float wl[5], wh[5];
#pragma unroll
            for (int j = 0; j < 5; ++j) { wl[j] = w[j * 256]; wh[j] = w[j * 256 + 1]; }
            const float scl = cmat ? 0.0625f : 1.0f;
            LAS unsigned char* dstS = lds + (cmat ? KS : QS) + (32 * rh) * QROW + chp2 * 2;
            float x0l = bflo(raw[0]), x0h = bfhi(raw[0]), x1l = bflo(raw[1]), x1h = bfhi(raw[1]), x2l = bflo(raw[2]), x2h = bfhi(raw[2]);
#pragma unroll
            for (int t = 0; t < 32; ++t) {
                const float x3l = bflo(raw[t + 3]), x3h = bfhi(raw[t + 3]);
                float ol = __builtin_fmaf(wl[0], x0l, wl[4]), oh = __builtin_fmaf(wh[0], x0h, wh[4]);
                ol = __builtin_fmaf(wl[1], x1l, ol); oh = __builtin_fmaf(wh[1], x1h, oh);
                ol = __builtin_fmaf(wl[2], x2l, ol); oh = __builtin_fmaf(wh[2], x2h, oh);
                ol = __builtin_fmaf(wl[3], x3l, ol); oh = __builtin_fmaf(wh[3], x3h, oh);
                ol = ol * sigmoidf_(ol) * scl; oh = oh * sigmoidf_(oh) * scl;
                *(LAS unsigned*)(dstS + t * QROW) = pk2(ol, oh);
                x0l = x1l; x0h = x1h; x1l = x2l; x1h = x2h; x2l = x3l; x2h = x3h;
            }
        }
        if (tid < 256) {
#pragma unroll
            for (int r = 0; r < 4; ++r) rv[r] = *(const u32x4*)(MLV + (rbase + vr0 + r) * DM + ecol + eg8);
#pragma unroll
            for (int r = 0; r < 4; ++r) {
                const float wsv = sc[S_WS / 4 + vr0 + r]; const u32x4 x = rv[r];
                *(LAS u32x4*)(lds + VS + (vr0 + r) * VROW + eg8 * 2) = x;
                *(LAS u32x4*)(lds + VW + (vr0 + r) * VROW + eg8 * 2) = (u32x4){pk2(bflo(x.x) * wsv, bfhi(x.x) * wsv), pk2(bflo(x.y) * wsv, bfhi(x.y) * wsv),
                                                                              pk2(bflo(x.z) * wsv, bfhi(x.z) * wsv), pk2(bflo(x.w) * wsv, bfhi(x.w) * wsv)};
            }
        }
#endif
        __syncthreads();
        if (c + 1 < nch) {
            const bf16_t* src = (cmat ? MLK : MLQ) + h * 256 + chp2 + (rbase + 64 + 32 * rh - 3) * DM;
#pragma unroll
            for (int r = 0; r < 35; ++r) raw[r] = *(const unsigned*)(src + (size_t)r * DM);
        }
#ifndef NO_S
        {
            const int tt = wid & 3, sh = wid >> 2;
            f32x4 sa[2] = {(f32x4){0.f, 0.f, 0.f, 0.f}, (f32x4){0.f, 0.f, 0.f, 0.f}};
            int qoff = QS + (16 * tt + fr) * QROW + 16 * g, koff = KS + (32 * sh + fr) * QROW + 16 * g;
            asm volatile("" : "+v"(qoff), "+v"(koff));
            bf16x8 sq[2][2], sk[2][2][2];
#define LD_S(bi, kp) do { _Pragma("unroll") for (int k2 = 0; k2 < 2; ++k2) { sq[bi][k2] = *(const LAS bf16x8*)(lds + qoff + 64 * (2 * (kp) + k2)); \
                _Pragma("unroll") for (int st2 = 0; st2 < 2; ++st2) sk[bi][k2][st2] = *(const LAS bf16x8*)(lds + koff + st2 * 16 * QROW + 64 * (2 * (kp) + k2)); } } while (0)
            LD_S(0, 0);
#pragma unroll
            for (int kp = 0; kp < 4; ++kp) {
                if (kp < 3) LD_S((kp + 1) & 1, kp + 1);
                __builtin_amdgcn_sched_barrier(0);
#pragma unroll
                for (int k2 = 0; k2 < 2; ++k2)
#pragma unroll
                    for (int st2 = 0; st2 < 2; ++st2) sa[st2] = __builtin_amdgcn_mfma_f32_16x16x32_bf16(sk[kp & 1][k2][st2], sq[kp & 1][k2], sa[st2], 0, 0, 0);
                __builtin_amdgcn_sched_barrier(0);
            }
#undef LD_S
            const int t = 16 * tt + fr; const float pmt = sc[S_PM / 4 + t]; float rs = 0.f;
#pragma unroll
            for (int st2 = 0; st2 < 2; ++st2) {
                const int s0 = 16 * (2 * sh + st2) + 4 * g;
                const f32x4 av = *(const LAS f32x4*)(sc + S_A / 4 + s0);
                float p[4];
#pragma unroll
                for (int jj = 0; jj < 4; ++jj) { p[jj] = (s0 + jj <= t) ? sa[st2][jj] * __expf(av[jj] - pmt) : 0.f; rs += p[jj]; }
                *(LAS u32x2*)(lds + PS + t * PROW + s0 * 2) = (u32x2){pk2(p[0], p[1]), pk2(p[2], p[3])};
            }
            rs += __shfl_xor(rs, 16); rs += __shfl_xor(rs, 32);
            if (g == 0) sc[(sh ? S_RS1 : S_RS0) / 4 + t] = rs;
            int tidS = tid; asm volatile("" : "+v"(tidS)); const int tq = tidS >> 3, part = tidS & 7; float d = 0.f;
#pragma unroll
            for (int i = 0; i < 4; ++i) {
                const u32x4 x = *(const LAS u32x4*)(lds + QS + tq * QROW + (32 * part + 8 * i) * 2);
                const f32x4 n0 = *(const LAS f32x4*)(nv + 32 * part + 8 * i), n1 = *(const LAS f32x4*)(nv + 32 * part + 8 * i + 4);
                d += bflo(x.x) * n0[0] + bfhi(x.x) * n0[1] + bflo(x.y) * n0[2] + bfhi(x.y) * n0[3] + bflo(x.z) * n1[0] + bfhi(x.z) * n1[1] + bflo(x.w) * n1[2] + bfhi(x.w) * n1[3];
            }
            d += __shfl_xor(d, 1); d += __shfl_xor(d, 2); d += __shfl_xor(d, 4);
            if (part == 0) sc[S_QN / 4 + tq] = d;
        }
#endif
        __syncthreads();
#ifndef NO_H
        {
            f32x4 ao[4] = {(f32x4){0.f, 0.f, 0.f, 0.f}, (f32x4){0.f, 0.f, 0.f, 0.f}, (f32x4){0.f, 0.f, 0.f, 0.f}, (f32x4){0.f, 0.f, 0.f, 0.f}};
            int qa = QS + fr * QROW + 8 * g;
            asm volatile("" : "+v"(qa));
            u32x2 xq[2][2][4][2];
#define LD_Q(bi, kp) do { _Pragma("unroll") for (int k2 = 0; k2 < 2; ++k2) _Pragma("unroll") for (int tt = 0; tt < 4; ++tt) { \
                xq[bi][k2][tt][0] = *(const LAS u32x2*)(lds + qa + tt * 16 * QROW + 64 * (2 * (kp) + k2)); xq[bi][k2][tt][1] = *(const LAS u32x2*)(lds + qa + tt * 16 * QROW + 64 * (2 * (kp) + k2) + 32); } } while (0)
            LD_Q(0, 0);
#pragma unroll
            for (int kp = 0; kp < 4; ++kp) {
                if (kp < 3) LD_Q((kp + 1) & 1, kp + 1);
                __builtin_amdgcn_sched_barrier(0);
                __builtin_amdgcn_s_setprio(1);
#pragma unroll
                for (int k2 = 0; k2 < 2; ++k2) {
                    const int kk = 2 * kp + k2;
                    const f32x4 c0 = accC[2 * kk], c1 = accC[2 * kk + 1];
                    const u32x4 bw = (u32x4){pk2(c0[0], c0[1]), pk2(c0[2], c0[3]), pk2(c1[0], c1[1]), pk2(c1[2], c1[3])};
                    const bf16x8 bfr = __builtin_bit_cast(bf16x8, bw);
#pragma unroll
                    for (int tt = 0; tt < 4; ++tt) {
                        const u32x2 x0 = xq[kp & 1][k2][tt][0], x1 = xq[kp & 1][k2][tt][1];
                        const bf16x8 afr = __builtin_bit_cast(bf16x8, (u32x4){x0.x, x0.y, x1.x, x1.y});
                        ao[tt] = __builtin_amdgcn_mfma_f32_16x16x32_bf16(afr, bfr, ao[tt], 0, 0, 0);
                    }
                }
                __builtin_amdgcn_s_setprio(0);
                __builtin_amdgcn_sched_barrier(0);
            }
#undef LD_Q
#pragma unroll
            for (int tt = 0; tt < 4; ++tt) { const f32x4 wi = *(const LAS f32x4*)(sc + S_WI / 4 + 16 * tt + 4 * g); ao[tt] = ao[tt] * wi; }
            const int q = (lane & 15) >> 2, p = lane & 3;
            int va = VS + (8 * g + q) * VROW + (e0 + 4 * p) * 2, pa = PS + fr * PROW + 16 * g;
            asm volatile("" : "+v"(va), "+v"(pa));
#pragma unroll
            for (int ks = 0; ks < 2; ++ks) {
                const s16x4 v0 = tr_read(lds + va + ks * 32 * VROW);
                const s16x4 v1 = tr_read(lds + va + ks * 32 * VROW + 4 * VROW);
                const bf16x8 bfr = (bf16x8){v0[0], v0[1], v0[2], v0[3], v1[0], v1[1], v1[2], v1[3]};
#pragma unroll
                for (int tt = 0; tt < 4; ++tt) {
                    const bf16x8 afr = *(const LAS bf16x8*)(lds + pa + tt * 16 * PROW + 64 * ks);
                    ao[tt] = __builtin_amdgcn_mfma_f32_16x16x32_bf16(afr, bfr, ao[tt], 0, 0, 0);
                }
            }
            int hoff = 4 * g * DM + ecol + e0 + fr;
            int sco = (par * S_PAR) + 16 * g;
            asm volatile("" : "+v"(hoff), "+v"(sco));
            bf16_t* hp = (bf16_t*)(ws + WS_B0 + 2 * SZ1) + rbase * DM + hoff;
#pragma unroll
            for (int tt = 0; tt < 4; ++tt) {
                const LAS unsigned char* sb = lds + SC + sco + 64 * tt;
                const f32x4 wi = *(const LAS f32x4*)(sb + S_WI), qn = *(const LAS f32x4*)(sb + S_QN), r0 = *(const LAS f32x4*)(sb + S_RS0),
                            r1 = *(const LAS f32x4*)(sb + S_RS1), em = *(const LAS f32x4*)(sb + S_EMT);
#pragma unroll
                for (int jj = 0; jj < 4; ++jj) {
                    const float den = wi[jj] * qn[jj] + r0[jj] + r1[jj];
                    const float hv = ao[tt][jj] * rcpf_(fmaxf(fabsf(den), em[jj]));
                    hp[(size_t)(16 * tt + jj) * DM] = (bf16_t)(pk2(hv, 0.f) & 0xffffu);
                }
                __builtin_amdgcn_sched_barrier(0);
            }
        }
#endif
#ifndef NO_CU
        {
            const float dec = sc[S_DEC / 4];
            const int q = (lane & 15) >> 2, p = lane & 3;
            int vwa = VW + (8 * g + q) * VROW + (e0 + 4 * p) * 2, ka = KS + (8 * g + q) * QROW + 8 * p;
            asm volatile("" : "+v"(vwa), "+v"(ka));
            bf16x8 bw[2];
#pragma unroll
            for (int ks = 0; ks < 2; ++ks) {
                const s16x4 v0 = tr_read(lds + vwa + ks * 32 * VROW);
                const s16x4 v1 = tr_read(lds + vwa + ks * 32 * VROW + 4 * VROW);
                bw[ks] = (bf16x8){v0[0], v0[1], v0[2], v0[3], v1[0], v1[1], v1[2], v1[3]};
            }
            s16x4 kr[2][2][2][2];
#define LD_K(bi, gp) do { _Pragma("unroll") for (int d4 = 0; d4 < 2; ++d4) _Pragma("unroll") for (int ks = 0; ks < 2; ++ks) { \
                kr[bi][d4][ks][0] = tr_read(lds + ka + ks * 32 * QROW + (2 * (gp) + d4) * 32); kr[bi][d4][ks][1] = tr_read(lds + ka + ks * 32 * QROW + (2 * (gp) + d4) * 32 + 4 * QROW); } } while (0)
            LD_K(0, 0);
#pragma unroll
            for (int gp = 0; gp < 8; ++gp) {
                if (gp < 7) LD_K((gp + 1) & 1, gp + 1);
                __builtin_amdgcn_sched_barrier(0);
                __builtin_amdgcn_s_setprio(1);
#pragma unroll
                for (int d4 = 0; d4 < 2; ++d4) {
                    const int dt = 2 * gp + d4;
                    accC[dt] = accC[dt] * dec;
#pragma unroll
                    for (int ks = 0; ks < 2; ++ks) {
                        const s16x4 k0 = kr[gp & 1][d4][ks][0], k1 = kr[gp & 1][d4][ks][1];
                        const bf16x8 afr = (bf16x8){k0[0], k0[1], k0[2], k0[3], k1[0], k1[1], k1[2], k1[3]};
                        accC[dt] = __builtin_amdgcn_mfma_f32_16x16x32_bf16(afr, bw[ks], accC[dt], 0, 0, 0);
                    }
                }
                __builtin_amdgcn_s_setprio(0);
                __builtin_amdgcn_sched_barrier(0);
            }
#undef LD_K
            int tidN = tid; asm volatile("" : "+v"(tidN)); const int dn = tidN >> 1, sh2 = tidN & 1; float sn = 0.f;
#pragma unroll 8
            for (int s = 0; s < 32; ++s) { const int ss = 32 * sh2 + s; sn += sc[S_WS / 4 + ss] * bf1(*(const LAS bf16_t*)(lds + KS + ss * QROW + dn * 2)); }
            sn += __shfl_xor(sn, 1);
            if (sh2 == 0) nv[dn] = dec * nv[dn] + sn;
        }
#endif
    }
    __syncthreads();
    {
        float* Co = out + (sample ? O_SC : O_PC) + (size_t)(b * 4 + h) * 65536;
#pragma unroll
        for (int dt = 0; dt < 16; ++dt)
#pragma unroll
            for (int jj = 0; jj < 4; ++jj) Co[(size_t)(16 * dt + 4 * g + jj) * 256 + half * 128 + e0 + fr] = accC[dt][jj];
        if (half == 0) {
            if (tid < 256) out[(sample ? O_SN : O_PN) + (size_t)(b * 4 + h) * 256 + tid] = nv[tid];
            if (tid == 0) out[(sample ? O_SM : O_PM) + b * 4 + h] = mstate;
        }
    }
    __syncthreads();
}
}

namespace at {
constexpr int KB = 0, VB = 18432, TB = 55296, KROW = 144, VROWA = 288, VBUF = 64 * VROWA;
__device__ __forceinline__ void attn_unit(const Args& a, LAS unsigned char* lds, bool sample, int b, int h, int c0, int nch) {
    const int tid = threadIdx.x, lane = tid & 63, wid = __builtin_amdgcn_readfirstlane(tid >> 6), fr = lane & 15, g = lane >> 4;
    unsigned char* ws = a.ws;
    const bf16_t* AQ = (const bf16_t*)(ws + WS_B0 + 4 * SZ1); const bf16_t* AK = (const bf16_t*)(a.out + O_Y); const bf16_t* AV = AK + (size_t)TT * DM; bf16_t* AO = (bf16_t*)(ws + WS_B0 + 4 * SZ1);
    const bf16_t* CK = (const bf16_t*)(ws + WS_CK); const bf16_t* CV = (const bf16_t*)(ws + WS_CV);
    const int cw = c0 + (wid >> 1), qh = wid & 1; const bool active = (wid >> 1) < nch;
    const size_t qrow0 = sample ? (size_t)TP + b * DSEQ + 32 * qh : (size_t)b * SEQ + (size_t)cw * 64 + 32 * qh;
    LAS float* tbl = (LAS float*)(lds + TB);
    if (tid < 320) tbl[tid] = a.in[I_RELB][h * 257 + (tid < 256 ? tid : 256)] * 1.4426950408889634f;
    bf16x8 qf[2][2];
    if (active) {
#pragma unroll
        for (int tt = 0; tt < 2; ++tt)
#pragma unroll
            for (int ks = 0; ks < 2; ++ks) qf[tt][ks] = *(const bf16x8*)(AQ + (qrow0 + 16 * tt + fr) * DM + h * 64 + 32 * ks + 8 * g);
    }
    const int jlo = sample ? 0 : (c0 - 8 > 0 ? c0 - 8 : 0), jhi = sample ? 8 : c0 + nch - 1;
    const int lrow = tid >> 3, lch = (tid & 7) * 8;
    auto kv_src = [&](int j, const bf16_t*& kp, const bf16_t*& vp) {
        if (sample) { if (j < 8) { const size_t o = ((size_t)b * NPAST + j * 64 + lrow) * DM + h * 64 + lch; kp = CK + o; vp = CV + o; }
                      else { const size_t o = ((size_t)TP + b * DSEQ + lrow) * DM + h * 64 + lch; kp = AK + o; vp = AV + o; } }
        else { const size_t o = ((size_t)b * SEQ + (size_t)j * 64 + lrow) * DM + h * 64 + lch; kp = AK + o; vp = AV + o; }
    };
    u32x4 kreg, vreg;
    { const bf16_t *kp, *vp; kv_src(jlo, kp, vp); kreg = *(const u32x4*)kp; vreg = *(const u32x4*)vp; }
    *(LAS u32x4*)(lds + KB + lrow * KROW + lch * 2) = kreg; *(LAS u32x4*)(lds + VB + lrow * VROWA + lch * 2) = vreg;
    f32x4 o[4][2];
#pragma unroll
    for (int et = 0; et < 4; ++et) { o[et][0] = (f32x4){0.f, 0.f, 0.f, 0.f}; o[et][1] = (f32x4){0.f, 0.f, 0.f, 0.f}; }
    float mrun[2] = {-INFINITY, -INFINITY}, lsum[2] = {0.f, 0.f};
    __syncthreads();
    for (int j = jlo; j <= jhi; ++j) {
        const int buf = (j - jlo) & 1;
        if (j < jhi) { const bf16_t *kp, *vp; kv_src(j + 1, kp, vp); kreg = *(const u32x4*)kp; vreg = *(const u32x4*)vp; }
        const int dq = (sample ? 8 : cw) - j;
        if (active && dq >= 0 && dq <= 8) {
            const LAS unsigned char* kb = lds + KB + buf * 9216; const LAS unsigned char* vb = lds + VB + buf * VBUF;
            f32x4 s[4][2];
#pragma unroll
            for (int st = 0; st < 4; ++st) { s[st][0] = (f32x4){0.f, 0.f, 0.f, 0.f}; s[st][1] = (f32x4){0.f, 0.f, 0.f, 0.f}; }
#pragma unroll
            for (int ks = 0; ks < 2; ++ks)
#pragma unroll
                for (int st = 0; st < 4; ++st) {
                    const bf16x8 kf = *(const LAS bf16x8*)(kb + (16 * st + fr) * KROW + (32 * ks + 8 * g) * 2);
                    s[st][0] = __builtin_amdgcn_mfma_f32_16x16x32_bf16(kf, qf[0][ks], s[st][0], 0, 0, 0);
                    s[st][1] = __builtin_amdgcn_mfma_f32_16x16x32_bf16(kf, qf[1][ks], s[st][1], 0, 0, 0);
                }
            const float bfar = tbl[256];
            constexpr float SC2 = 0.125f * 1.4426950408889634f;
            if (dq < 3) {
                const int relb = 64 * dq + 32 * qh + fr - 4 * g + 128;
#pragma unroll
                for (int tt = 0; tt < 2; ++tt)
#pragma unroll
                    for (int st = 0; st < 4; ++st)
#pragma unroll
                        for (int jj = 0; jj < 4; ++jj) s[st][tt][jj] = __builtin_fmaf(s[st][tt][jj], SC2, tbl[relb + 16 * tt - 16 * st - jj]);
            } else {
#pragma unroll
                for (int tt = 0; tt < 2; ++tt)
#pragma unroll
                    for (int st = 0; st < 4; ++st) s[st][tt] = s[st][tt] * SC2 + bfar;
            }
#pragma unroll
            for (int tt = 0; tt < 2; ++tt) {
                float mx = fmaxf(fmaxf(s[0][tt][0], s[0][tt][1]), fmaxf(s[0][tt][2], s[0][tt][3]));
#pragma unroll
                for (int st = 1; st < 4; ++st) mx = fmaxf(fmaxf(mx, s[st][tt][0]), fmaxf(fmaxf(s[st][tt][1], s[st][tt][2]), s[st][tt][3]));
                mx = fmaxf(mx, __shfl_xor(mx, 16)); mx = fmaxf(mx, __shfl_xor(mx, 32));
                const float mnew = fmaxf(mrun[tt], mx), alpha = __builtin_amdgcn_exp2f(mrun[tt] - mnew);
                const bool chg = mnew > mrun[tt]; mrun[tt] = mnew;
                f32x4 psv = (f32x4){0.f, 0.f, 0.f, 0.f}; const float nmn = -mnew; const f32x4 nm4 = (f32x4){nmn, nmn, nmn, nmn};
#pragma unroll
                for (int st = 0; st < 4; ++st) {
                    const f32x4 d = s[st][tt] + nm4;
                    const f32x4 pv4 = (f32x4){__builtin_amdgcn_exp2f(d[0]), __builtin_amdgcn_exp2f(d[1]), __builtin_amdgcn_exp2f(d[2]), __builtin_amdgcn_exp2f(d[3])};
                    s[st][tt] = pv4; psv = psv + pv4;
                }
                lsum[tt] = lsum[tt] * alpha + ((psv[0] + psv[1]) + (psv[2] + psv[3]));
                if (__any(chg)) {
#pragma unroll
                    for (int et = 0; et < 4; ++et) o[et][tt] = o[et][tt] * alpha;
                }
            }
            const int q = (lane & 15) >> 2, p = lane & 3;
#pragma unroll
            for (int ks2 = 0; ks2 < 2; ++ks2) {
                bf16x8 pf[2];
#pragma unroll
                for (int tt = 0; tt < 2; ++tt) { const f32x4 p0 = s[2 * ks2][tt], p1 = s[2 * ks2 + 1][tt];
                    pf[tt] = __builtin_bit_cast(bf16x8, (u32x4){pk2(p0[0], p0[1]), pk2(p0[2], p0[3]), pk2(p1[0], p1[1]), pk2(p1[2], p1[3])}); }
#pragma unroll
                for (int et = 0; et < 4; ++et) {
                    const s16x4 v0 = tr_read(vb + (32 * ks2 + 4 * g + q) * VROWA + (16 * et + 4 * p) * 2);
                    const s16x4 v1 = tr_read(vb + (32 * ks2 + 16 + 4 * g + q) * VROWA + (16 * et + 4 * p) * 2);
                    const bf16x8 vf = (bf16x8){v0[0], v0[1], v0[2], v0[3], v1[0], v1[1], v1[2], v1[3]};
                    o[et][0] = __builtin_amdgcn_mfma_f32_16x16x32_bf16(vf, pf[0], o[et][0], 0, 0, 0);
                    o[et][1] = __builtin_amdgcn_mfma_f32_16x16x32_bf16(vf, pf[1], o[et][1], 0, 0, 0);
                }
            }
        }
        if (j < jhi) { *(LAS u32x4*)(lds + KB + (buf ^ 1) * 9216 + lrow * KROW + lch * 2) = kreg; *(LAS u32x4*)(lds + VB + (buf ^ 1) * VBUF + lrow * VROWA + lch * 2) = vreg; }
        __syncthreads();
    }
    if (active) {
#pragma unroll
        for (int tt = 0; tt < 2; ++tt) {
            float l = lsum[tt]; l += __shfl_xor(l, 16); l += __shfl_xor(l, 32);
            const float inv = 1.f / l;
#pragma unroll
            for (int et = 0; et < 4; ++et) {
                const f32x4 v = o[et][tt] * inv;
                *(u32x2*)(AO + (qrow0 + 16 * tt + fr) * DM + h * 64 + 16 * et + 4 * g) = (u32x2){pk2(v[0], v[1]), pk2(v[2], v[3])};
            }
        }
    }
}
}

constexpr int NPHASE = 14;
__global__ void __launch_bounds__(512, 2) mega_fwd(Args args) {
    extern __shared__ __attribute__((aligned(16))) unsigned char lds_raw[];
    LAS unsigned char* lds = (LAS unsigned char*)lds_raw;
    unsigned char* ws = args.ws;
    float* U = args.out + O_Y;
    bf16_t* HB = (bf16_t*)(ws + WS_HB);
    bf16_t* UB = (bf16_t*)(ws + WS_B0 + 3 * SZ1);
    bf16_t* ACT = (bf16_t*)(ws + WS_ACT);
    const int lo = args.ph_lo, hi = args.ph_hi;
    const int G = gridDim.x, blk = blockIdx.x;
#ifndef PH_MASK
#define PH_MASK 0xFFFF
#endif
#define IN(k) (((PH_MASK >> (k)) & 1) && lo <= (k) && (k) < hi)
#ifndef DUP_MASK
#define DUP_MASK 0
#endif
#define REP(k) for (int rep_ = 0; rep_ < 1 + ((DUP_MASK >> (k)) & 1); ++rep_)
    volatile LAS unsigned* bst = (volatile LAS unsigned*)(lds + LDS_BYTES - 64);
    if (threadIdx.x < 2) bst[threadIdx.x] = 0u;
    __syncthreads();
    if (hi - lo > 1) (void)xcd_barrier_post((unsigned*)(ws + WS_BAR), bst);
#define SEAM(k) do { if (IN(k) && IN((k) + 1)) { if ((k) == 0) cg::this_grid().sync(); else xcd_barrier((unsigned*)(args.ws + WS_BAR), (volatile LAS unsigned*)(lds + LDS_BYTES - 64)); } } while (0)

    if (IN(0)) { p0_prologue(args, lds); if (DUP_MASK & 1) { __syncthreads(); p0_prologue(args, lds); } }
    SEAM(0);
    if (IN(1)) {
        pg8::Gemm g{}; g.A[0] = HB; g.Bt[0] = (const bf16_t*)(ws + WS_WGU1); g.M = TT; g.N = 2 * FF; g.K = DM;
        pg8::StaticOrder S; S.init(TT, 2 * FF, G, blk, 1);
        pg8::EpiSwiglu E{ACT};
        pg8::gemm_phase(lds, g, S, E);
        if ((DUP_MASK >> 1) & 1) pg8::gemm_phase(lds, g, S, E);
    }
    SEAM(1);
    if (IN(2)) {
        pg8::Gemm g{}; g.A[0] = ACT; g.Bt[0] = (const bf16_t*)(ws + WS_WD1); g.M = TT; g.N = DM; g.K = FF;
        pg8::StaticOrder S; S.init(TP, DM, G, blk, 1);
        pg8::EpiResid E{UB, nullptr, nullptr, HB, 0.5f, 1};
        pg8::gemm_phase(lds, g, S, E);
    }
    SEAM(2);
    if (IN(3)) {
        if (blk < 16) {
            pg8::Gemm g{}; g.A[0] = ACT; g.Bt[0] = (const bf16_t*)(ws + WS_WD1); g.M = TT; g.N = DM; g.K = FF;
            pg8::StaticOrder S; S.init(TS, DM, G, blk, 1, TP / 256);
            pg8::EpiResid E{UB, nullptr, nullptr, HB, 0.5f, 1};
            pg8::gemm_phase(lds, g, S, E);
        } else {
            ln_pass<1>(UB, nullptr, HB, args.in[I_LN1G], args.in[I_LN1B], (const float*)(ws + WS_WIF), (float*)(ws + WS_IF), 0, TP, 16, G - 16);
            const size_t gt2 = (size_t)(blk - 16) * 512 + threadIdx.x, NT2 = (size_t)(G - 16) * 512;
            cvt_f32_bf16(args.in[I_CK], (bf16_t*)(ws + WS_CK), (size_t)NSB * NPAST * DM / 8, gt2, NT2);
            cvt_f32_bf16(args.in[I_CV], (bf16_t*)(ws + WS_CV), (size_t)NSB * NPAST * DM / 8, gt2, NT2);
        }
        xcd_barrier((unsigned*)(args.ws + WS_BAR), (volatile LAS unsigned*)(lds + LDS_BYTES - 64));
        ln_pass<1>(UB, nullptr, HB, args.in[I_LN1G], args.in[I_LN1B], (const float*)(ws + WS_WIF), (float*)(ws + WS_IF), TP, TT, 0, G);
    }
    SEAM(3);
    if (IN(4)) {
        pg8::Gemm g{}; g.A[0] = HB; g.Bt[0] = (const bf16_t*)(ws + WS_WML); g.M = TT; g.N = 7168; g.K = DM;
        pg8::StaticOrder S; S.init(TT, 7168, G, blk, 1);
        pg8::EpiSplitBf16 E{}; for (int i = 0; i < 5; ++i) E.dst[i] = (bf16_t*)(ws + WS_B0 + i * SZ1); E.dst[5] = (bf16_t*)U; E.dst[6] = (bf16_t*)U + (size_t)TT * DM;
        E.pk = args.out + O_PK; E.sk = args.out + O_SK; E.pv = args.out + O_PV; E.sv = args.out + O_SV; E.kt = 5; E.vt = 6;
        pg8::gemm_phase(lds, g, S, E);
    }
    SEAM(4);
    if (IN(5)) {
        for (int it = blk; it < 384; it += G) {
            int item = it;
            if (G == 256) {
                if (it < 256) { const int x = it & 7, j = it >> 3; item = ((x * 16 + (j >> 1)) << 1) | (j & 1); }
                else { const int sidx = it - 256, x = sidx & 7, j = sidx >> 3; item = 256 + (((x * 8 + (j >> 1)) << 1) | (j & 1)); }
            }
            ml::mlstm_item(args, lds, item);
        }
    }
    SEAM(5);
    if (IN(6)) {
        headln_pass((bf16_t*)(ws + WS_B0 + 2 * SZ1), (const bf16_t*)(ws + WS_B0 + 3 * SZ1), args.in[I_MLNG]);
    }
    if (IN(7)) {
        for (int u = blk; u < 4096 + 256; u += G) {
            if (u < 4096) { const int i = u >> 8, bb = u & 255, quad = i & 7, bh = (i >> 3) * 256 + bb; at::attn_unit(args, lds, false, bh >> 4, bh & 15, quad * 4, 4); }
            else { const int s = u - 4096; at::attn_unit(args, lds, true, s >> 4, s & 15, 8, 1); }
        }
    }
    SEAM(7);
    if (IN(8)) {
        pg8::Gemm g{}; g.A[0] = HB; g.A[1] = (const bf16_t*)(ws + WS_B0 + 2 * SZ1); g.A[2] = HB; g.A[3] = (const bf16_t*)(ws + WS_B0 + 4 * SZ1);
        g.Bt[0] = (const bf16_t*)(ws + WS_WGM); g.Bt[1] = (const bf16_t*)(ws + WS_WMLP); g.Bt[2] = (const bf16_t*)(ws + WS_WGA); g.Bt[3] = (const bf16_t*)(ws + WS_WATTP);
        g.M = TT; g.N = DM; g.K = DM;
        pg8::StaticOrder S; S.init(TP, DM, G, blk, 4);
        pg8::EpiMerge E{(bf16_t*)(ws + WS_B0), (u32x4*)(ws + WS_GSCR) + (size_t)blk * 48 * 512};
        pg8::gemm_phase(lds, g, S, E);
    }
    SEAM(8);
    if (IN(9)) {
        if (blk < 16) {
            pg8::Gemm g{}; g.A[0] = HB; g.A[1] = (const bf16_t*)(ws + WS_B0 + 2 * SZ1); g.A[2] = HB; g.A[3] = (const bf16_t*)(ws + WS_B0 + 4 * SZ1);
            g.Bt[0] = (const bf16_t*)(ws + WS_WGM); g.Bt[1] = (const bf16_t*)(ws + WS_WMLP); g.Bt[2] = (const bf16_t*)(ws + WS_WGA); g.Bt[3] = (const bf16_t*)(ws + WS_WATTP);
            g.M = TT; g.N = DM; g.K = DM;
            pg8::StaticOrder S; S.init(TS, DM, G, blk, 4, TP / 256);
            pg8::EpiMerge E{(bf16_t*)(ws + WS_B0), (u32x4*)(ws + WS_GSCR) + (size_t)blk * 48 * 512};
            pg8::gemm_phase(lds, g, S, E);
        } else {
            pg8::Gemm g{}; g.A[0] = (const bf16_t*)(ws + WS_B0); g.Bt[0] = (const bf16_t*)(ws + WS_WOUT); g.M = TT; g.N = DM; g.K = DM;
            pg8::StaticOrder S; S.init(TP, DM, G - 16, blk - 16, 1);
            pg8::EpiResid E{UB, nullptr, nullptr, HB, 1.0f, 1};
            pg8::gemm_phase(lds, g, S, E);
        }
    }
    SEAM(9);
    if (IN(10)) {
        if (blk < 16) {
            pg8::Gemm g{}; g.A[0] = (const bf16_t*)(ws + WS_B0); g.Bt[0] = (const bf16_t*)(ws + WS_WOUT); g.M = TT; g.N = DM; g.K = DM;
            pg8::StaticOrder S; S.init(TS, DM, G, blk, 1, TP / 256);
            pg8::EpiResid E{UB, nullptr, nullptr, HB, 1.0f, 1};
            pg8::gemm_phase(lds, g, S, E);
        } else {
            ln_pass<2>(UB, nullptr, HB, args.in[I_LN2G], args.in[I_LN2B], nullptr, nullptr, 0, TP, 16, G - 16);
        }
        xcd_barrier((unsigned*)(args.ws + WS_BAR), (volatile LAS unsigned*)(lds + LDS_BYTES - 64));
        ln_pass<2>(UB, nullptr, HB, args.in[I_LN2G], args.in[I_LN2B], nullptr, nullptr, TP, TT, 0, G);
    }
    SEAM(10);
    if (IN(11)) {
        pg8::Gemm g{}; g.A[0] = HB; g.Bt[0] = (const bf16_t*)(ws + WS_WGU2); g.M = TT; g.N = 2 * FF; g.K = DM;
        pg8::StaticOrder S; S.init(TT, 2 * FF, G, blk, 1);
        pg8::EpiSwiglu E{ACT};
        pg8::gemm_phase(lds, g, S, E);
        if ((DUP_MASK >> 11) & 1) pg8::gemm_phase(lds, g, S, E);
    }
    SEAM(11);
    if (IN(12)) {
        pg8::Gemm g{}; g.A[0] = ACT; g.Bt[0] = (const bf16_t*)(ws + WS_WD2); g.M = TT; g.N = DM; g.K = FF;
        pg8::StaticOrder S; S.init(TP, DM, G, blk, 1);
        pg8::EpiResid E{UB, nullptr, nullptr, HB, 0.5f, 1};
        pg8::gemm_phase(lds, g, S, E);
    }
    SEAM(12);
    if (IN(13)) {
        if (blk < 16) {
            pg8::Gemm g{}; g.A[0] = ACT; g.Bt[0] = (const bf16_t*)(ws + WS_WD2); g.M = TT; g.N = DM; g.K = FF;
            pg8::StaticOrder S; S.init(TS, DM, G, blk, 1, TP / 256);
            pg8::EpiResid E{UB, nullptr, nullptr, HB, 0.5f, 1};
            pg8::gemm_phase(lds, g, S, E);
        } else {
            ln_pass<3>(UB, U, nullptr, args.in[I_LN3G], args.in[I_LN3B], nullptr, nullptr, 0, TP, 16, G - 16);
        }
        xcd_barrier((unsigned*)(args.ws + WS_BAR), (volatile LAS unsigned*)(lds + LDS_BYTES - 64));
        ln_pass<3>(UB, U, nullptr, args.in[I_LN3G], args.in[I_LN3B], nullptr, nullptr, TP, TT, 0, G);
    }
#undef IN
#undef SEAM
}

extern "C" void kernel_launch(void* const* d_in, const int* in_sizes, int n_in, void* d_out, int out_size, void* d_ws, size_t ws_size, hipStream_t stream) {
    static int grid = 0;
    if (grid == 0) {
        if (n_in != 28 || ws_size < WS_END || (size_t)out_size != O_END) {
            fprintf(stderr, "kernel_launch: unexpected sizes n_in %d ws %zu (need %zu) out %d (expect %zu)\n", n_in, ws_size, (size_t)WS_END, out_size, (size_t)O_END);
            if (n_in != 28 || ws_size < WS_END) { grid = -1; return; }
        }
        (void)hipFuncSetAttribute((const void*)mega_fwd, hipFuncAttributeMaxDynamicSharedMemorySize, LDS_BYTES);
        int dev = 0, cus = 0, per_cu = 0;
        (void)hipGetDevice(&dev); (void)hipDeviceGetAttribute(&cus, hipDeviceAttributeMultiprocessorCount, dev);
        (void)hipOccupancyMaxActiveBlocksPerMultiprocessor(&per_cu, (const void*)mega_fwd, 512, LDS_BYTES);
        if (per_cu < 1) fprintf(stderr, "kernel_launch: occupancy query says %d blocks/CU\n", per_cu);
        (void)hipGetLastError();
        grid = cus > 0 ? cus : 256;
    }
    if (grid < 0) return;
    Args a{};
    for (int i = 0; i < 28; ++i) a.in[i] = (const float*)d_in[i];
    a.out = (float*)d_out; a.ws = (unsigned char*)d_ws;
#if MK_ONE_LAUNCH
    (void)hipMemsetAsync((char*)d_ws + WS_BAR, 0, 16384, stream);
    a.ph_lo = 0; a.ph_hi = NPHASE;
    void* kargs[] = {&a};
    hipError_t e = hipLaunchCooperativeKernel((const void*)mega_fwd, dim3(grid), dim3(512), kargs, LDS_BYTES, stream);
    if (e != hipSuccess) fprintf(stderr, "cooperative launch failed: %s (grid %d)\n", hipGetErrorString(e), grid);
#else
    for (int p = 0; p < NPHASE; ++p) { a.ph_lo = p; a.ph_hi = p + 1; hipLaunchKernelGGL(mega_fwd, dim3(grid), dim3(512), LDS_BYTES, stream, a); }
#endif
}
```
